# Optimizing an MI355X kernel written in HIP

```python
import jax
import jax.numpy as jnp
from jax import lax
import numpy as np

D_MODEL = 2048
BATCH = 2
SEQ = 4096
DEPTH = 2
DEC_BATCH = 128
DEC_SEQ = 4
PAST_LEN = 8192
PAGE_SIZE = 128

N_MIXERS = 2
HEAD_DIM = 64
N_HEADS = D_MODEL // HEAD_DIM
N_KV_HEADS = max(1, N_HEADS // 8)
GQA_GROUP = N_HEADS // N_KV_HEADS
QKV_WIDTH = (N_HEADS + 2 * N_KV_HEADS) * HEAD_DIM
WINDOW = 128
ATTN_BLOCK = WINDOW
ATTN_SCALE = HEAD_DIM ** -0.5
ROPE_THETA = 10000.0
D_FF = ((8 * D_MODEL // 3 + 255) // 256) * 256
D_DECAY_LORA = 96
D_AAA_LORA = 96
D_GATE_LORA = 256
N_SUBLAYERS = 3
N_MOD = 3 * N_SUBLAYERS
MACARON_WEIGHT = 0.5
RMS_EPS = 1e-6
GN_EPS = 64e-5
N_RWKV = (DEPTH + N_MIXERS - 1) // N_MIXERS
N_ATTN = DEPTH // N_MIXERS

kernel_name = 'rwkv7_swa_sink_macaron_adaln_step'


def rms_norm(x, g):
    xf = x.astype(jnp.float32)
    y = xf * lax.rsqrt(jnp.mean(xf * xf, axis=-1, keepdims=True) + RMS_EPS)
    return (y * g.astype(jnp.float32)).astype(x.dtype)


def modulate(h, shift, scale):
    return h * (1.0 + scale[:, None, :]) + shift[:, None, :]


def swiglu(h, w_in, w_out):
    gate, up = jnp.split(h @ w_in, 2, axis=-1)
    return (jax.nn.silu(gate) * up) @ w_out


def rope(x, pos):
    half = HEAD_DIM // 2
    inv_freq = ROPE_THETA ** (-jnp.arange(half, dtype=jnp.float32) / half)
    ang = pos.astype(jnp.float32)[:, None] * inv_freq[None, :]
    cos = jnp.cos(ang)[None, :, None, :]
    sin = jnp.sin(ang)[None, :, None, :]
    xf = x.astype(jnp.float32)
    x1, x2 = xf[..., :half], xf[..., half:]
    return jnp.concatenate([x1 * cos - x2 * sin, x2 * cos + x1 * sin], axis=-1).astype(x.dtype)


def rwkv7_time_mix(h, shift0, wkv0, p):
    mu, w_rkv, w0, w1, w2, a0, a1, a2, g1, g2, k_k, k_a, r_k, gn_w, gn_b, w_o = p
    B, T, D = h.shape
    f32 = jnp.float32
    prev = jnp.concatenate([shift0[:, None, :].astype(h.dtype), h[:, :-1]], axis=1)
    xx = prev - h
    xr, xw, xk, xv, xa, xg = [h + xx * mu[i] for i in range(6)]
    r = xr @ w_rkv[0]
    k = xk @ w_rkv[1]
    v = xv @ w_rkv[2]
    log_w = -jax.nn.softplus(-(w0 + jnp.tanh(xw @ w1) @ w2)) - 0.5
    a = jax.nn.sigmoid(a0 + (xa @ a1) @ a2)
    g = jax.nn.sigmoid(xg @ g1) @ g2
    heads = lambda t: t.astype(f32).reshape(B, T, N_HEADS, HEAD_DIM)
    kk = heads(k * k_k)
    kk = kk / jnp.maximum(jnp.sqrt(jnp.sum(kk * kk, axis=-1, keepdims=True)), 1e-12)
    k = k * (1.0 + (a - 1.0) * k_a)
    rh, kh, vh, ah = heads(r), heads(k), heads(v), heads(a)
    decay = jnp.exp(-jnp.exp(heads(log_w)))

    def step(S, inp):
        r_t, w_t, k_t, v_t, kk_t, a_t = inp
        s_kk = jnp.einsum('bhvk,bhk->bhv', S, kk_t)
        S = (S * w_t[:, :, None, :]
             - s_kk[..., None] * (kk_t * a_t)[:, :, None, :]
             + v_t[..., None] * k_t[:, :, None, :])
        return S, jnp.einsum('bhvk,bhk->bhv', S, r_t)

    xs = tuple(jnp.swapaxes(t, 0, 1) for t in (rh, decay, kh, vh, kk, ah))
    wkv_T, y = lax.scan(step, wkv0.astype(f32), xs)
    y = jnp.swapaxes(y, 0, 1)
    mean = jnp.mean(y, axis=-1, keepdims=True)
    var = jnp.mean(jnp.square(y - mean), axis=-1, keepdims=True)
    y = ((y - mean) * lax.rsqrt(var + GN_EPS)).reshape(B, T, D) * gn_w.astype(f32) + gn_b.astype(f32)
    bonus = jnp.sum(rh * kh * r_k.astype(f32), axis=-1, keepdims=True) * vh
    y = y + bonus.reshape(B, T, D)
    out = (y * g.astype(f32)).astype(h.dtype) @ w_o
    return out, wkv_T.astype(wkv0.dtype), h[:, -1]


def swa_qkv(h, pos, w_qkv, b_qkv):
    B, T, _ = h.shape
    qkv = h @ w_qkv + b_qkv
    nq = N_HEADS * HEAD_DIM
    nkv = N_KV_HEADS * HEAD_DIM
    q = qkv[..., :nq].reshape(B, T, N_HEADS, HEAD_DIM)
    k = qkv[..., nq:nq + nkv].reshape(B, T, N_KV_HEADS, HEAD_DIM)
    v = qkv[..., nq + nkv:].reshape(B, T, N_KV_HEADS, HEAD_DIM)
    return rope(q, pos), rope(k, pos), v


def sink_softmax(scores, visible, sink):
    s = jnp.where(visible, scores, -jnp.inf)
    sk = sink.astype(jnp.float32).reshape(N_KV_HEADS, GQA_GROUP)[:, :, None, None]
    m = jnp.maximum(jnp.max(s, axis=-1, keepdims=True), sk)
    p = jnp.exp(s - m)
    return p / (jnp.sum(p, axis=-1, keepdims=True) + jnp.exp(sk - m))


def swa_prompt_attend(q, k, v, sink):
    B, S = q.shape[:2]
    nb = S // ATTN_BLOCK
    qb = q.reshape(B, nb, ATTN_BLOCK, N_KV_HEADS, GQA_GROUP, HEAD_DIM)

    def with_prev(t):
        tb = t.reshape(B, nb, ATTN_BLOCK, N_KV_HEADS, HEAD_DIM)
        prev = jnp.concatenate([jnp.zeros_like(tb[:, :1]), tb[:, :-1]], axis=1)
        return jnp.concatenate([prev, tb], axis=2)

    kw, vw = with_prev(k), with_prev(v)
    scores = jnp.einsum('bnqkgd,bnskd->bnkgqs', qb, kw,
                        preferred_element_type=jnp.float32) * ATTN_SCALE
    blk = jnp.arange(nb)[:, None] * ATTN_BLOCK
    qpos = blk + jnp.arange(ATTN_BLOCK)[None, :]
    kpos = blk - ATTN_BLOCK + jnp.arange(2 * ATTN_BLOCK)[None, :]
    rel = qpos[:, :, None] - kpos[:, None, :]
    visible = (rel >= 0) & (rel < WINDOW) & (kpos[:, None, :] >= 0)
    probs = sink_softmax(scores, visible[None, :, None, None], sink)
    out = jnp.einsum('bnkgqs,bnskd->bnqkgd', probs.astype(v.dtype), vw)
    return out.reshape(B, S, N_HEADS * HEAD_DIM)


def swa_cached_attend(q, k_new, v_new, k_cache, v_cache, sink, past_len):
    B, T = q.shape[:2]
    W = k_cache.shape[1]
    kc = jnp.concatenate([k_cache, k_new.astype(k_cache.dtype)], axis=1)
    vc = jnp.concatenate([v_cache, v_new.astype(v_cache.dtype)], axis=1)
    qg = q.reshape(B, T, N_KV_HEADS, GQA_GROUP, HEAD_DIM)
    scores = jnp.einsum('btkgd,bskd->bkgts', qg, kc,
                        preferred_element_type=jnp.float32) * ATTN_SCALE
    qpos = past_len + jnp.arange(T)
    kpos = past_len - W + jnp.arange(W + T)
    rel = qpos[:, None] - kpos[None, :]
    visible = (rel >= 0) & (rel < WINDOW)
    probs = sink_softmax(scores, visible, sink)
    out = jnp.einsum('bkgts,bskd->btkgd', probs.astype(vc.dtype), vc)
    return out.reshape(B, T, N_HEADS * HEAD_DIM), kc[:, -W:], vc[:, -W:]


def trunk(x, c, pos0, wkv_in, shift_in, k_in, v_in, shared, rw, sw):
    norm_g, w_ada, b_ada, w_ffn_in, w_ffn_out, final_g = shared
    B, T, D = x.shape
    new_wkv, new_shift, new_k, new_v = [], [], [], []
    for i in range(DEPTH):
        mod = (jax.nn.silu(c) @ w_ada[i] + b_ada[i]).reshape(B, N_MOD, D)
        h = modulate(rms_norm(x, norm_g[i, 0]), mod[:, 0], mod[:, 1])
        x = x + MACARON_WEIGHT * mod[:, 2, None, :] * swiglu(h, w_ffn_in[i, 0], w_ffn_out[i, 0])
        h = modulate(rms_norm(x, norm_g[i, 1]), mod[:, 3], mod[:, 4])
        j = i // N_MIXERS
        if i % N_MIXERS == 0:
            wkv0 = jnp.zeros((B, N_HEADS, HEAD_DIM, HEAD_DIM), x.dtype) if wkv_in is None else wkv_in[j]
            sh0 = jnp.zeros((B, D), x.dtype) if shift_in is None else shift_in[j]
            out, wkv_T, last = rwkv7_time_mix(h, sh0, wkv0, tuple(t[j] for t in rw))
            new_wkv.append(wkv_T)
            new_shift.append(last)
        else:
            w_qkv, b_qkv, sink, w_o, b_o = (t[j] for t in sw)
            q, k, v = swa_qkv(h, pos0 + jnp.arange(T), w_qkv, b_qkv)
            if k_in is None:
                att = swa_prompt_attend(q, k, v, sink)
                kw, vw = k[:, -WINDOW:], v[:, -WINDOW:]
            else:
                att, kw, vw = swa_cached_attend(q, k, v, k_in[j], v_in[j], sink, pos0)
            out = att @ w_o + b_o
            new_k.append(kw)
            new_v.append(vw)
        x = x + mod[:, 5, None, :] * out
        h = modulate(rms_norm(x, norm_g[i, 2]), mod[:, 6], mod[:, 7])
        x = x + MACARON_WEIGHT * mod[:, 8, None, :] * swiglu(h, w_ffn_in[i, 1], w_ffn_out[i, 1])
    y = rms_norm(x, final_g)
    return y, jnp.stack(new_wkv), jnp.stack(new_shift), jnp.stack(new_k), jnp.stack(new_v)


def setup_inputs(seed: int = 0) -> dict:
    key = jax.random.key(seed)
    keys = iter(jax.random.split(key, 48))
    f32 = jnp.float32
    D = D_MODEL
    win = min(WINDOW, PAST_LEN)

    def normal(shape, scale):
        return jax.random.normal(next(keys), shape, f32) * scale

    inp = {}
    inp['x_prompt'] = normal((BATCH, SEQ, D), 1.0)
    inp['x_sample'] = normal((DEC_BATCH, DEC_SEQ, D), 1.0)
    inp['state_rwkv_wkv'] = normal((N_RWKV, DEC_BATCH, N_HEADS, HEAD_DIM, HEAD_DIM), 1.0)
    inp['state_rwkv_shift'] = normal((N_RWKV, DEC_BATCH, D), 1.0)
    inp['cache_swa_k'] = normal((N_ATTN, DEC_BATCH, win, N_KV_HEADS, HEAD_DIM), 1.0)
    inp['cache_swa_v'] = normal((N_ATTN, DEC_BATCH, win, N_KV_HEADS, HEAD_DIM), 1.0)
    inp['c_prompt'] = normal((BATCH, D), 1.0)
    inp['c_sample'] = normal((DEC_BATCH, D), 1.0)
    inp['norm_g'] = 1.0 + normal((DEPTH, N_SUBLAYERS, D), 0.02)
    inp['w_ada'] = normal((DEPTH, D, N_MOD * D), D ** -0.5)
    inp['b_ada'] = normal((DEPTH, N_MOD * D), 0.02)
    inp['w_ffn_in'] = normal((DEPTH, 2, D, 2 * D_FF), D ** -0.5)
    inp['w_ffn_out'] = normal((DEPTH, 2, D_FF, D), D_FF ** -0.5)
    inp['rw_mu'] = jax.random.uniform(next(keys), (N_RWKV, 6, D), f32)
    inp['rw_wrkv'] = normal((N_RWKV, 3, D, D), D ** -0.5)
    inp['rw_w0'] = normal((N_RWKV, D), 0.5) - 1.0
    inp['rw_w1'] = normal((N_RWKV, D, D_DECAY_LORA), D ** -0.5)
    inp['rw_w2'] = normal((N_RWKV, D_DECAY_LORA, D), 0.5 * D_DECAY_LORA ** -0.5)
    inp['rw_a0'] = normal((N_RWKV, D), 0.1)
    inp['rw_a1'] = normal((N_RWKV, D, D_AAA_LORA), D ** -0.5)
    inp['rw_a2'] = normal((N_RWKV, D_AAA_LORA, D), D_AAA_LORA ** -0.5)
    inp['rw_g1'] = normal((N_RWKV, D, D_GATE_LORA), D ** -0.5)
    inp['rw_g2'] = normal((N_RWKV, D_GATE_LORA, D), D_GATE_LORA ** -0.5)
    inp['rw_kk'] = 0.85 + normal((N_RWKV, D), 0.02)
    inp['rw_ka'] = 1.0 + normal((N_RWKV, D), 0.02)
    inp['rw_rk'] = normal((N_RWKV, N_HEADS, HEAD_DIM), 0.1)
    inp['rw_gn_w'] = 1.0 + normal((N_RWKV, D), 0.02)
    inp['rw_gn_b'] = normal((N_RWKV, D), 0.02)
    inp['rw_wo'] = normal((N_RWKV, D, D), D ** -0.5)
    inp['sw_wqkv'] = normal((N_ATTN, D, QKV_WIDTH), D ** -0.5)
    inp['sw_bqkv'] = normal((N_ATTN, QKV_WIDTH), 0.02)
    inp['sw_sink'] = normal((N_ATTN, N_HEADS), 0.5)
    inp['sw_wo'] = normal((N_ATTN, N_HEADS * HEAD_DIM, D), (N_HEADS * HEAD_DIM) ** -0.5)
    inp['sw_bo'] = normal((N_ATTN, D), 0.02)
    inp['final_g'] = 1.0 + normal((D,), 0.02)
    return inp


def reference(x_prompt, x_sample, state_rwkv_wkv, state_rwkv_shift, cache_swa_k, cache_swa_v,
              c_prompt, c_sample, norm_g, w_ada, b_ada, w_ffn_in, w_ffn_out,
              rw_mu, rw_wrkv, rw_w0, rw_w1, rw_w2, rw_a0, rw_a1, rw_a2, rw_g1, rw_g2,
              rw_kk, rw_ka, rw_rk, rw_gn_w, rw_gn_b, rw_wo,
              sw_wqkv, sw_bqkv, sw_sink, sw_wo, sw_bo, final_g):
    shared = (norm_g, w_ada, b_ada, w_ffn_in, w_ffn_out, final_g)
    rw = (rw_mu, rw_wrkv, rw_w0, rw_w1, rw_w2, rw_a0, rw_a1, rw_a2, rw_g1, rw_g2,
          rw_kk, rw_ka, rw_rk, rw_gn_w, rw_gn_b, rw_wo)
    sw = (sw_wqkv, sw_bqkv, sw_sink, sw_wo, sw_bo)
    y_prompt, p_wkv, p_shift, p_k, p_v = trunk(
        x_prompt, c_prompt, 0, None, None, None, None, shared, rw, sw)
    y_sample, s_wkv, s_shift, s_k, s_v = trunk(
        x_sample, c_sample, PAST_LEN, state_rwkv_wkv, state_rwkv_shift,
        cache_swa_k, cache_swa_v, shared, rw, sw)
    return (y_prompt, y_sample, p_wkv, p_shift, p_k, p_v, s_wkv, s_shift, s_k, s_v)
```

```cpp
#include <hip/hip_runtime.h>
#include <cstdio>
#include <cstdint>

#define LAS __attribute__((address_space(3)))
#define GAS __attribute__((address_space(1)))
typedef unsigned short bf16_t;
typedef short bf16x8 __attribute__((ext_vector_type(8)));
typedef short s16x4 __attribute__((ext_vector_type(4)));
typedef float f32x4 __attribute__((ext_vector_type(4)));
typedef float f32x2 __attribute__((ext_vector_type(2)));
typedef float f32x16 __attribute__((ext_vector_type(16)));
typedef unsigned u32x4 __attribute__((ext_vector_type(4)));
typedef unsigned u32x2 __attribute__((ext_vector_type(2)));
typedef __bf16 bf16x2_t __attribute__((ext_vector_type(2)));

#ifndef PROBE_MASK
#define PROBE_MASK 0
#endif
#ifndef MK_PER_PHASE
#define MK_PER_PHASE 0
#endif

constexpr int D = 2048, NPR = 8192, NSR = 512, M = NPR + NSR, SEQ = 4096, NCB = 130, FF = 5632, NH = 32, HD = 64, KVH = 4;
constexpr int QKVW = 2560, NMOD = 9, DEC_B = 128, DEC_T = 4, WIN = 128;
constexpr float RMS_EPS = 1e-6f, GN_EPS = 64e-5f, LOG2E = 1.4426950408889634f;
constexpr float QSCALE = 0.125f * LOG2E;
constexpr int NWAVES = 8, NTHREADS = 512;

constexpr size_t O_Y = 0, O_PWKV = 17825792, O_PSHIFT = 18087936, O_PK = 18092032, O_PV = 18157568, O_SWKV = 18223104, O_SSHIFT = 35000320, O_SK = 35262464, O_SV = 39456768, O_END = 43651072;

constexpr size_t MiB = 1u << 20;
constexpr size_t WS_CTL = 0, CTL_ZERO_BYTES = 1 * MiB;
constexpr size_t WS_WADA = 1 * MiB;
constexpr size_t WS_WFIN = 145 * MiB;
constexpr size_t WS_WFOUT = 321 * MiB;
constexpr size_t WS_WRKVL1 = 409 * MiB;
constexpr size_t WS_WL2 = 436 * MiB;
constexpr size_t WS_WRWO = 439 * MiB;
constexpr size_t WS_WQKV = 447 * MiB;
constexpr size_t WS_WSWO = 457 * MiB;
constexpr size_t WS_CS = 465 * MiB;
constexpr size_t WS_MOD = 466 * MiB;
constexpr size_t WS_X = 485 * MiB;
constexpr size_t WS_HA = 553 * MiB;
constexpr size_t WS_ARENA = 587 * MiB;
constexpr size_t WS_ACT = WS_ARENA;
constexpr size_t WS_XA6 = WS_ARENA;
constexpr size_t WS_DAG = WS_ARENA;
constexpr size_t WS_RKV = WS_ARENA + 204 * MiB;
constexpr size_t WS_L1OUT = WS_ARENA + 436 * MiB;
constexpr size_t WS_YRAW = WS_ARENA + 449 * MiB;
constexpr size_t WS_QKV = WS_ARENA;
constexpr size_t WS_QB = WS_ARENA + 85 * MiB;
constexpr size_t WS_KB = WS_ARENA + 119 * MiB;
constexpr size_t WS_VB = WS_ARENA + 124 * MiB;
constexpr size_t WS_SLAB = WS_ARENA + 517 * MiB;
constexpr size_t WS_DELTA = WS_ARENA + 565 * MiB;
constexpr size_t WS_X2 = WS_ARENA + 633 * MiB;
constexpr size_t WS_END = WS_ARENA + 701 * MiB;
constexpr int PMS_QKV = 25, ROW0_QKV = PMS_QKV * 256, NROWS_QKV = M - ROW0_QKV;
constexpr int LDR = 6912;
constexpr int CW_BAR = 4096;

constexpr int RING_BYTES = 131072, LDSCTL_OFF = RING_BYTES, MISC_OFF = LDSCTL_OFF + 320, LDS_BYTES = 147456;
constexpr int QCTR_OFF = LDSCTL_OFF + 1024;

#define RLX_AGENT __ATOMIC_RELAXED, __HIP_MEMORY_SCOPE_AGENT
#define LDS_WAIT() asm volatile("s_waitcnt lgkmcnt(0)" ::: "memory")
__device__ __forceinline__ unsigned cvtpk(float lo, float hi) { f32x2 v = {lo, hi}; bf16x2_t b = __builtin_convertvector(v, bf16x2_t); return __builtin_bit_cast(unsigned, b); }
__device__ __forceinline__ float bf2f(unsigned short u) { return __builtin_bit_cast(float, (unsigned)u << 16); }
__device__ __forceinline__ f32x4 bf4(u32x2 w) { return (f32x4){__builtin_bit_cast(float, w.x << 16), __builtin_bit_cast(float, w.x & 0xffff0000u), __builtin_bit_cast(float, w.y << 16), __builtin_bit_cast(float, w.y & 0xffff0000u)}; }
template <int CTRL> __device__ __forceinline__ float dppf(float x) { return __builtin_bit_cast(float, __builtin_amdgcn_update_dpp(0, __builtin_bit_cast(int, x), CTRL, 0xf, 0xf, false)); }
template <int CTRL> __device__ __forceinline__ float dppm(float x) { return __builtin_bit_cast(float, __builtin_amdgcn_update_dpp(0x3f800000, __builtin_bit_cast(int, x), CTRL, 0xf, 0xf, false)); }
__device__ __forceinline__ float row16_sum(float x) {
    x += dppf<0x128>(x); x += dppf<0x124>(x); x += dppf<0x122>(x); x += dppf<0x121>(x); return x;
}
__device__ __forceinline__ float xor16f(float x) { return __builtin_bit_cast(float, __builtin_amdgcn_ds_swizzle(__builtin_bit_cast(int, x), 0x401F)); }
__device__ __forceinline__ float other32(float x, int lane) { return __builtin_bit_cast(float, __builtin_amdgcn_ds_bpermute((lane ^ 32) << 2, __builtin_bit_cast(int, x))); }
__device__ __forceinline__ float sum_xor32(float x, int lane) { return x + other32(x, lane); }
__device__ __forceinline__ float max_xor32(float x, int lane) { return fmaxf(x, other32(x, lane)); }
__device__ __forceinline__ float wave_sum(float v) { v = row16_sum(v);
    const float a = __builtin_bit_cast(float, __builtin_amdgcn_readlane(__builtin_bit_cast(int, v), 0)), b = __builtin_bit_cast(float, __builtin_amdgcn_readlane(__builtin_bit_cast(int, v), 16));
    const float c = __builtin_bit_cast(float, __builtin_amdgcn_readlane(__builtin_bit_cast(int, v), 32)), d = __builtin_bit_cast(float, __builtin_amdgcn_readlane(__builtin_bit_cast(int, v), 48));
    return (a + b) + (c + d); }
__device__ __forceinline__ float fexp2(float x) { return __builtin_amdgcn_exp2f(x); }
__device__ __forceinline__ float frcp(float x) { return __builtin_amdgcn_rcpf(x); }
__device__ __forceinline__ float sigmoidf_(float x) { return frcp(1.f + fexp2(-x * LOG2E)); }
__device__ __forceinline__ float siluf_(float x) { return x * sigmoidf_(x); }
__device__ __forceinline__ float tanhf_(float x) { return 1.f - 2.f * frcp(1.f + fexp2(2.f * LOG2E * x)); }
__device__ __forceinline__ int bidx_of_row(int m) { return m < NPR ? (m >> 12) : 2 + ((m - NPR) >> 2); }

namespace pg8 {
constexpr int BM = 256, BK = 64, HALF = 128, HTB = HALF * BK * 2, STAGE_BYTES = 8 * HTB, NXCD = 8, WGM = 8;
__host__ __device__ __forceinline__ int lds_byte(int r, int c) { const int st = (r >> 4) * 2 + (c >> 5), rr = r & 15, cc = c & 31, ob = rr * 64 + cc * 2; return st * 1024 + (ob ^ (((ob >> 9) & 1) << 5)); }
__host__ __device__ __forceinline__ void stage_rc(int b, int& R, int& C) { const int st = b / 1024, sb = b % 1024, swz = sb ^ (((sb >> 9) & 1) << 5); R = (st >> 1) * 16 + swz / 64; C = (st & 1) * 32 + (swz % 64) / 2; }
__host__ __device__ __forceinline__ int perm32(int rho) { const int n = rho >> 4, i = rho & 15; return 8 * (i >> 2) + 4 * n + (i & 3); }

struct Unit { int pm, pn, s; };

template <int NM, int NN> struct StaticOrderT {
    static __device__ __forceinline__ void map(int L, int& pm, int& pn) {
        constexpr int nwg = NM * NN, q = nwg / NXCD, r = nwg % NXCD, nig = WGM * NN, tail = (NM % WGM) ? (NM % WGM) : WGM, lastfm = NM - tail;
        const int xcd = L % NXCD, off = L / NXCD; const int wgid = (xcd < r ? xcd * (q + 1) : r * (q + 1) + (xcd - r) * q) + off;
        const int gid = wgid / nig, fm = gid * WGM, rem = wgid - gid * nig;
        const int pmA = rem % WGM, pnA = rem / WGM, pmB = rem % tail, pnB = rem / tail;
        const bool last = fm >= lastfm;
        pm = fm + (last ? pmB : pmA); pn = last ? pnB : pnA;
    }
};
template <int NM, int NN, int NKF, int PMS, int S> struct SplitOrder {
    int G, c;
    __device__ __forceinline__ void init(int G_, int c_) { G = G_; c = c_; }
    __device__ __forceinline__ bool next(int i, int& pm, int& pn, int& s) const {
        constexpr int nfull = PMS * NN, total = nfull + (NM - PMS) * NN * S;
        const int L = i * G + c; if (L >= total) return false;
        int pm1, pn1; StaticOrderT<PMS, NN>::map(L < nfull ? L : 0, pm1, pn1);
        const int j = L - nfull, r = j / S, s2 = j - r * S, pm2 = PMS + r / NN, pn2 = r % NN;
        const bool full = L < nfull;
        pm = full ? pm1 : pm2; pn = full ? pn1 : pn2; s = full ? -1 : s2;
        return true;
    }
    static __device__ __forceinline__ int k0(const Unit& u) { return u.s < 0 ? 0 : u.s * (NKF / S); }
    static __device__ __forceinline__ int nk(const Unit& u) { return u.s < 0 ? NKF : NKF / S; }
};
struct ASel0   { __device__ __forceinline__ int operator()(int) const { return 0; } };
struct ASelRKV { __device__ __forceinline__ int operator()(int pn) const { const int a = pn >> 3, b = pn - 24; return (a < 3 ? a : 3) + (b > 0 ? b : 0); } };
struct ASelL2  { __device__ __forceinline__ int operator()(int pn) const { return pn >> 3; } };
template <class ASel, class Ord> struct Sched {
    Ord ord; const char* A; const char* Bt; size_t tstep, astride; ASel asel;
    __device__ __forceinline__ bool next(int i, int& pm, int& pn, int& s) const { return ord.next(i, pm, pn, s); }
    __device__ __forceinline__ const char* pa(const Unit& u) const { return A + (size_t)asel(u.pn) * astride + (size_t)u.pm * tstep + (size_t)Ord::k0(u) * (BK * 2); }
    __device__ __forceinline__ const char* pb(const Unit& u) const { return Bt + (size_t)u.pn * tstep + (size_t)Ord::k0(u) * (BK * 2); }
    __device__ __forceinline__ int nk(const Unit& u) const { return Ord::nk(u); }
};

template <class Epi, class SchedT>
__device__ __forceinline__ void gemm_phase(LAS unsigned char* lds, const int tid, const int K, const SchedT& S, const Epi& E) {
    const int wid = __builtin_amdgcn_readfirstlane(tid >> 6), lane = tid & 63, wr = wid >> 2, wc = wid & 3, fr = lane & 15, fq = lane >> 4;
    unsigned voffA[2], voffB[2];
#pragma unroll
    for (int i = 0; i < 2; ++i) { int R, C; stage_rc(tid * 16 + i * 8192, R, C); const int Rb = Epi::PERM ? ((R & ~31) + perm32(R & 31)) : R;
        voffA[i] = (unsigned)(R * K + C) * 2u; voffB[i] = (unsigned)(Rb * K + C) * 2u; }
    const size_t kstep = (size_t)(BK * 2);
    const size_t hstep = (size_t)HALF * K * 2;
    const unsigned ldsw = (unsigned)wid * 1024u;
    const int aoff = lds_byte(wr * 64 + fr, fq * 8), boff = lds_byte(wc * 32 + fr, fq * 8);
#define PG8_SA(b, h) (((b) * 2 + (h)) * HTB)
#define PG8_SB(b, h) ((4 + (b) * 2 + (h)) * HTB)
#define PG8_STAGE(bufoff, gbase, voff) do { _Pragma("unroll") for (int _i = 0; _i < 2; ++_i) \
        __builtin_amdgcn_global_load_lds((const unsigned*)((const char*)(gbase) + (voff)[_i]), (LAS unsigned*)(lds + (bufoff) + ldsw + _i * 8192), 16, 0, 0); } while (0)
#define PG8_LDA(dst, b, h) do { _Pragma("unroll") for (int m = 0; m < 4; ++m) _Pragma("unroll") for (int k = 0; k < 2; ++k) dst[m][k] = *(const LAS bf16x8*)(lds + PG8_SA(b, h) + aoff + m * 2048 + k * 1024); } while (0)
#define PG8_LDB(dst, b, h) do { _Pragma("unroll") for (int n = 0; n < 2; ++n) _Pragma("unroll") for (int k = 0; k < 2; ++k) dst[n][k] = *(const LAS bf16x8*)(lds + PG8_SB(b, h) + boff + n * 2048 + k * 1024); } while (0)
#define PG8_MMA(ai, bj, At, Bt) do { __builtin_amdgcn_s_setprio(1); _Pragma("unroll") for (int m = 0; m < 4; ++m) _Pragma("unroll") for (int n = 0; n < 2; ++n) _Pragma("unroll") for (int k = 0; k < 2; ++k) \
        acc[ai][bj][m][n] = __builtin_amdgcn_mfma_f32_16x16x32_bf16(Bt[n][k], At[m][k], acc[ai][bj][m][n], 0, 0, 0); __builtin_amdgcn_s_setprio(0); } while (0)
#define PG8_WAIT_V(n) asm volatile("s_waitcnt vmcnt(" #n ")" ::: "memory")
#define PG8_WAIT_L(n) asm volatile("s_waitcnt lgkmcnt(" #n ")" ::: "memory")
#define PG8_BAR __builtin_amdgcn_s_barrier()
#define PG8_SCHED __builtin_amdgcn_sched_barrier(0)
    int cpm, cpn, cs, npm = 0, npn = 0, ns = -1, ui = 0;
    if (!S.next(0, cpm, cpn, cs)) return;
    const char* cA = S.pa(Unit{cpm, cpn, cs}); const char* cB = S.pb(Unit{cpm, cpn, cs});
    PG8_STAGE(PG8_SB(0, 0), cB, voffB); PG8_STAGE(PG8_SB(0, 1), cB + hstep, voffB); PG8_STAGE(PG8_SA(0, 0), cA, voffA); PG8_STAGE(PG8_SA(0, 1), cA + hstep, voffA);
    if (wr == 1) PG8_BAR;
    PG8_WAIT_V(2); PG8_BAR;
    PG8_STAGE(PG8_SB(1, 0), cB + kstep, voffB); PG8_STAGE(PG8_SA(1, 0), cA + kstep, voffA); PG8_STAGE(PG8_SB(1, 1), cB + hstep + kstep, voffB);
    PG8_WAIT_V(6); PG8_BAR;
    f32x4 acc[2][2][4][2];
#pragma unroll
    for (int a = 0; a < 2; ++a)
#pragma unroll
        for (int b = 0; b < 2; ++b)
#pragma unroll
            for (int m = 0; m < 4; ++m)
#pragma unroll
                for (int n = 0; n < 2; ++n) acc[a][b][m][n] = (f32x4){0.f, 0.f, 0.f, 0.f};
    bf16x8 At[4][2], B0[2][2], B1[2][2];
    for (;;) {
        const bool has_next = S.next(ui + 1, npm, npn, ns);
        const char* nA = has_next ? S.pa(Unit{npm, npn, ns}) : cA; const char* nB = has_next ? S.pb(Unit{npm, npn, ns}) : cB;
        const int nt = S.nk(Unit{cpm, cpn, cs});
#pragma unroll 1
        for (int t = 0; t < nt; t += 2) {
            const bool last = (t == nt - 2);
            const char* a1 = cA + (size_t)(t + 1) * kstep;
            const char* a2 = last ? nA : cA + (size_t)(t + 2) * kstep; const char* b2 = last ? nB : cB + (size_t)(t + 2) * kstep;
            const char* a3 = a2 + kstep; const char* b3 = b2 + kstep;
            PG8_LDB(B0, 0, 0); PG8_LDB(B1, 0, 1); PG8_SCHED; PG8_LDA(At, 0, 0); PG8_STAGE(PG8_SA(1, 1), a1 + hstep, voffA);
            PG8_WAIT_V(8); PG8_WAIT_L(0); PG8_BAR; PG8_MMA(0, 0, At, B0); PG8_MMA(0, 1, At, B1); PG8_BAR; PG8_SCHED;
            PG8_LDA(At, 0, 1); PG8_STAGE(PG8_SB(0, 0), b2, voffB); PG8_STAGE(PG8_SB(0, 1), b2 + hstep, voffB); PG8_STAGE(PG8_SA(0, 0), a2, voffA);
            PG8_WAIT_V(8); PG8_WAIT_L(0); PG8_BAR; PG8_MMA(1, 0, At, B0); PG8_MMA(1, 1, At, B1); PG8_BAR; PG8_SCHED;
            PG8_LDB(B0, 1, 0); PG8_LDB(B1, 1, 1); PG8_SCHED; PG8_LDA(At, 1, 0); PG8_STAGE(PG8_SA(0, 1), a2 + hstep, voffA);
            PG8_WAIT_V(8); PG8_WAIT_L(0); PG8_BAR; PG8_MMA(0, 0, At, B0); PG8_MMA(0, 1, At, B1); PG8_BAR; PG8_SCHED;
            PG8_LDA(At, 1, 1); PG8_STAGE(PG8_SB(1, 0), b3, voffB); PG8_STAGE(PG8_SB(1, 1), b3 + hstep, voffB); PG8_STAGE(PG8_SA(1, 0), a3, voffA);
            PG8_WAIT_V(8); PG8_WAIT_L(0); PG8_BAR; PG8_MMA(1, 0, At, B0); PG8_MMA(1, 1, At, B1); PG8_BAR; PG8_SCHED;
        }
        if (wr == 0) PG8_BAR;
        E(acc, Unit{cpm, cpn, cs}, wr, wc, fr, fq);
        if (!has_next) break;
#pragma unroll
        for (int a = 0; a < 2; ++a)
#pragma unroll
            for (int b = 0; b < 2; ++b)
#pragma unroll
                for (int m = 0; m < 4; ++m)
#pragma unroll
                    for (int n = 0; n < 2; ++n) acc[a][b][m][n] = (f32x4){0.f, 0.f, 0.f, 0.f};
        cpm = npm; cpn = npn; cs = ns; cA = nA; cB = nB; ++ui;
        if (wr == 1) PG8_BAR;
    }
    PG8_WAIT_V(0);
    PG8_BAR;
#undef PG8_SA
#undef PG8_SB
#undef PG8_STAGE
#undef PG8_LDA
#undef PG8_LDB
#undef PG8_MMA
#undef PG8_WAIT_V
#undef PG8_WAIT_L
#undef PG8_BAR
#undef PG8_SCHED
}

struct EpiAda { static constexpr bool PERM = false; float* mod; const float* bias;
    __device__ __forceinline__ void operator()(const f32x4 (&acc)[2][2][4][2], const Unit& u, int wr, int wc, int fr, int fq) const {
        const int col0 = u.pn * BM + wc * 32 + 4 * fq;
#pragma unroll
        for (int ai = 0; ai < 2; ++ai)
#pragma unroll
            for (int m = 0; m < 4; ++m) { const int row = ai * HALF + wr * 64 + m * 16 + fr;
                if (row < NCB) {
#pragma unroll
                    for (int bj = 0; bj < 2; ++bj)
#pragma unroll
                        for (int n = 0; n < 2; ++n) { const int j = col0 + bj * HALF + n * 16; const int l = j >= 18432 ? 1 : 0, jj = j - l * 18432;
                            *(f32x4*)(mod + ((size_t)l * NCB + row) * 18432 + jj) = acc[ai][bj][m][n] + *(const f32x4*)(bias + j); } } }
    }
};
struct EpiSwiglu { static constexpr bool PERM = true; bf16_t* act;
    __device__ __forceinline__ void operator()(const f32x4 (&acc)[2][2][4][2], const Unit& u, int wr, int wc, int fr, int fq) const {
        const int col0 = u.pn * HALF + wc * 32 + 8 * fq;
#pragma unroll
        for (int ai = 0; ai < 2; ++ai)
#pragma unroll
            for (int m = 0; m < 4; ++m) { const int row = u.pm * BM + ai * HALF + wr * 64 + m * 16 + fr;
                const f32x4 g0 = acc[ai][0][m][0], g1 = acc[ai][0][m][1], u0 = acc[ai][1][m][0], u1 = acc[ai][1][m][1];
                u32x4 w; w.x = cvtpk(siluf_(g0[0]) * u0[0], siluf_(g0[1]) * u0[1]); w.y = cvtpk(siluf_(g0[2]) * u0[2], siluf_(g0[3]) * u0[3]);
                w.z = cvtpk(siluf_(g1[0]) * u1[0], siluf_(g1[1]) * u1[1]); w.w = cvtpk(siluf_(g1[2]) * u1[2], siluf_(g1[3]) * u1[3]);
                *(u32x4*)(act + (size_t)row * FF + col0) = w; }
    }
};
__device__ __forceinline__ void slab_store(const f32x4 (&acc)[2][2][4][2], const Unit& u, int wr, int wc, int fr, int fq, float* slab, int row0, int nrows, int ldc) {
    float* base = slab + (size_t)u.s * ((size_t)nrows * ldc) + u.pn * BM + wc * 32 + 4 * fq;
#pragma unroll
    for (int ai = 0; ai < 2; ++ai)
#pragma unroll
        for (int m = 0; m < 4; ++m) { const int row = u.pm * BM + ai * HALF + wr * 64 + m * 16 + fr - row0;
#pragma unroll
            for (int bj = 0; bj < 2; ++bj)
#pragma unroll
                for (int n = 0; n < 2; ++n) *(f32x4*)(base + (size_t)row * ldc + bj * HALF + n * 16) = acc[ai][bj][m][n]; }
}
__device__ __forceinline__ void slab_store_bf(const f32x4 (&acc)[2][2][4][2], const Unit& u, int wr, int wc, int fr, int fq, bf16_t* slab, int row0, int nrows, int ldc) {
    bf16_t* base = slab + (size_t)u.s * ((size_t)nrows * ldc) + u.pn * BM + wc * 32 + 4 * fq;
#pragma unroll
    for (int ai = 0; ai < 2; ++ai)
#pragma unroll
        for (int m = 0; m < 4; ++m) { const int row = u.pm * BM + ai * HALF + wr * 64 + m * 16 + fr - row0;
#pragma unroll
            for (int bj = 0; bj < 2; ++bj)
#pragma unroll
                for (int n = 0; n < 2; ++n) { const f32x4 v = acc[ai][bj][m][n]; u32x2 w; w.x = cvtpk(v[0], v[1]); w.y = cvtpk(v[2], v[3]);
                    *(u32x2*)(base + (size_t)row * ldc + bj * HALF + n * 16) = w; } }
}
struct EpiDelta { static constexpr bool PERM = false; bf16_t* dl; float* slab;
    __device__ __forceinline__ void operator()(const f32x4 (&acc)[2][2][4][2], const Unit& u, int wr, int wc, int fr, int fq) const {
        if (u.s >= 0) { slab_store_bf(acc, u, wr, wc, fr, fq, (bf16_t*)slab, NPR, NSR, D); return; }
        const int col0 = u.pn * BM + wc * 32 + 4 * fq;
#pragma unroll
        for (int ai = 0; ai < 2; ++ai)
#pragma unroll
            for (int m = 0; m < 4; ++m) { const int row = u.pm * BM + ai * HALF + wr * 64 + m * 16 + fr;
#pragma unroll
                for (int bj = 0; bj < 2; ++bj)
#pragma unroll
                    for (int n = 0; n < 2; ++n) { const f32x4 v = acc[ai][bj][m][n]; u32x2 w; w.x = cvtpk(v[0], v[1]); w.y = cvtpk(v[2], v[3]);
                        *(u32x2*)(dl + (size_t)row * D + col0 + bj * HALF + n * 16) = w; } }
    }
};
struct EpiL2 { static constexpr bool PERM = false; float* dag; const float* w0; const float* a0;
    __device__ __forceinline__ void operator()(const f32x4 (&acc)[2][2][4][2], const Unit& u, int wr, int wc, int fr, int fq) const {
        const int kind = u.pn >> 3, col0 = (u.pn & 7) * BM + wc * 32 + 4 * fq;
        float* base = dag + (size_t)kind * ((size_t)M * D) + col0;
        f32x4 bv[2][2];
#pragma unroll
        for (int bj = 0; bj < 2; ++bj)
#pragma unroll
            for (int n = 0; n < 2; ++n) bv[bj][n] = kind == 0 ? *(const f32x4*)(w0 + col0 + bj * HALF + n * 16) : kind == 1 ? *(const f32x4*)(a0 + col0 + bj * HALF + n * 16) : (f32x4){0.f, 0.f, 0.f, 0.f};
#pragma unroll
        for (int ai = 0; ai < 2; ++ai)
#pragma unroll
            for (int m = 0; m < 4; ++m) { const int row = u.pm * BM + ai * HALF + wr * 64 + m * 16 + fr;
#pragma unroll
                for (int bj = 0; bj < 2; ++bj)
#pragma unroll
                    for (int n = 0; n < 2; ++n) { f32x4 v = acc[ai][bj][m][n] + bv[bj][n];
                        if (kind == 0) {
#pragma unroll
                            for (int e = 0; e < 4; ++e) v[e] = fexp2(-0.60653066f * LOG2E * sigmoidf_(v[e]));
                        } else if (kind == 1) {
#pragma unroll
                            for (int e = 0; e < 4; ++e) v[e] = sigmoidf_(v[e]);
                        }
                        if (kind == 2) { u32x2 w; w.x = cvtpk(v[0], v[1]); w.y = cvtpk(v[2], v[3]); *(u32x2*)((bf16_t*)(dag + (size_t)2 * ((size_t)M * D)) + (size_t)row * D + col0 + bj * HALF + n * 16) = w; }
                        else *(f32x4*)(base + (size_t)row * D + bj * HALF + n * 16) = v; }
                asm volatile("" ::: "memory"); }
    }
};
struct EpiRKV { static constexpr bool PERM = false; float* out; bf16_t* l1;
    __device__ __forceinline__ void operator()(const f32x4 (&acc)[2][2][4][2], const Unit& u, int wr, int wc, int fr, int fq) const {
        if (u.pn >= 24) {
            const int kind = u.pn - 24; bf16_t* base = l1 + (size_t)kind * ((size_t)M * 256) + wc * 32 + 4 * fq;
#pragma unroll
            for (int ai = 0; ai < 2; ++ai)
#pragma unroll
                for (int m = 0; m < 4; ++m) { const int row = u.pm * BM + ai * HALF + wr * 64 + m * 16 + fr;
#pragma unroll
                    for (int bj = 0; bj < 2; ++bj)
#pragma unroll
                        for (int n = 0; n < 2; ++n) { f32x4 v = acc[ai][bj][m][n];
                            if (kind == 0) { v[0] = tanhf_(v[0]); v[1] = tanhf_(v[1]); v[2] = tanhf_(v[2]); v[3] = tanhf_(v[3]); }
                            else if (kind == 2) { v[0] = sigmoidf_(v[0]); v[1] = sigmoidf_(v[1]); v[2] = sigmoidf_(v[2]); v[3] = sigmoidf_(v[3]); }
                            u32x2 w; w.x = cvtpk(v[0], v[1]); w.y = cvtpk(v[2], v[3]);
                            *(u32x2*)(base + (size_t)row * 256 + bj * HALF + n * 16) = w; }
                    asm volatile("" ::: "memory"); }
            return; }
        const int col0 = u.pn * BM + wc * 32 + 4 * fq;
#pragma unroll
        for (int ai = 0; ai < 2; ++ai)
#pragma unroll
            for (int m = 0; m < 4; ++m) { const int row = u.pm * BM + ai * HALF + wr * 64 + m * 16 + fr;
#pragma unroll
                for (int bj = 0; bj < 2; ++bj)
#pragma unroll
                    for (int n = 0; n < 2; ++n) *(f32x4*)(out + (size_t)row * LDR + col0 + bj * HALF + n * 16) = acc[ai][bj][m][n]; }
    }
};
struct EpiF32 { static constexpr bool PERM = false; float* out; int ldc; const float* bias; float* slab; int row0, nrows;
    __device__ __forceinline__ void operator()(const f32x4 (&acc)[2][2][4][2], const Unit& u, int wr, int wc, int fr, int fq) const {
        if (u.s >= 0) { slab_store(acc, u, wr, wc, fr, fq, slab, row0, nrows, ldc); return; }
        const int col0 = u.pn * BM + wc * 32 + 4 * fq;
        f32x4 bv[2][2];
#pragma unroll
        for (int bj = 0; bj < 2; ++bj)
#pragma unroll
            for (int n = 0; n < 2; ++n) bv[bj][n] = bias ? *(const f32x4*)(bias + col0 + bj * HALF + n * 16) : (f32x4){0.f, 0.f, 0.f, 0.f};
#pragma unroll
        for (int ai = 0; ai < 2; ++ai)
#pragma unroll
            for (int m = 0; m < 4; ++m) { const int row = u.pm * BM + ai * HALF + wr * 64 + m * 16 + fr;
#pragma unroll
                for (int bj = 0; bj < 2; ++bj)
#pragma unroll
                    for (int n = 0; n < 2; ++n) *(f32x4*)(out + (size_t)row * ldc + col0 + bj * HALF + n * 16) = acc[ai][bj][m][n] + bv[bj][n]; }
    }
};
}

#define XB_TMO      128
#define XB_XCNT(j)  (256  + 64 * (j))
#define XB_XSUB(j)  (1280 + 64 * (j))
#define XB_XGEN(j)  (2304 + 64 * (j))
#define XB_TOP      3328
#define XB_TOPGEN   3392
#define XCD_BAR_WORDS 3456
#define XB_SPIN_CAP (1u << 18)
__device__ __forceinline__ unsigned xb_ld(unsigned* p)              { return __hip_atomic_load(p, __ATOMIC_RELAXED, __HIP_MEMORY_SCOPE_AGENT); }
__device__ __forceinline__ unsigned xb_add(unsigned* p, unsigned v) { return __hip_atomic_fetch_add(p, v, __ATOMIC_RELAXED, __HIP_MEMORY_SCOPE_AGENT); }
__device__ __forceinline__ unsigned xb_xcc_id() { return (unsigned)__builtin_amdgcn_s_getreg((3 << 11) | 20) & 0xFu; }
#define XB_SPIN(cond, bar) do { unsigned _sp = 0; while (cond) { __builtin_amdgcn_s_sleep(1); \
    if ((++_sp & 255u) == 0u) { if (xb_ld(&(bar)[XB_TMO])) break; if (_sp > XB_SPIN_CAP) { atomicAdd(&(bar)[XB_TMO], 1u); break; } } } } while (0)
struct XcdBarrier { unsigned* bar; unsigned x; volatile LAS unsigned* st; };
__device__ __forceinline__ XcdBarrier xcd_barrier_post(unsigned* bar, volatile LAS unsigned* st) {
    XcdBarrier b; b.bar = bar; b.x = xb_xcc_id(); b.st = st;
    if (threadIdx.x == 0) (void)xb_add(&bar[XB_XCNT(b.x)], 1u);
    return b;
}
__device__ __forceinline__ void xcd_barrier_complete(unsigned* bar, unsigned x, unsigned& nloc, unsigned& nx) {
    const unsigned G = gridDim.x * gridDim.y * gridDim.z;
    unsigned sum, cnt, mine, sp = 0u;
    for (;;) {
        sum = 0u; cnt = 0u; mine = 0u;
#pragma unroll
        for (unsigned j = 0; j < 16; ++j) { const unsigned c = xb_ld(&bar[XB_XCNT(j)]); sum += c; cnt += (c > 0u) ? 1u : 0u; mine = (j == x) ? c : mine; }
        if (sum == G) break;
        __builtin_amdgcn_s_sleep(1);
        if ((++sp & 255u) == 0u) { if (xb_ld(&bar[XB_TMO])) break; if (sp > XB_SPIN_CAP) { atomicAdd(&bar[XB_TMO], 1u); break; } }
    }
    nloc = mine > 0u ? mine : 1u; nx = cnt > 0u ? cnt : 1u;
}
__device__ __forceinline__ void xcd_barrier(const XcdBarrier& b) {
    asm volatile("s_waitcnt vmcnt(0)" ::: "memory");
    __syncthreads();
    if (threadIdx.x == 0) {
        unsigned* bar = b.bar;
        __builtin_amdgcn_s_waitcnt(0);
        unsigned nloc = b.st[0], nx = b.st[1];
        if (nloc == 0u) { xcd_barrier_complete(bar, b.x, nloc, nx); b.st[0] = nloc; b.st[1] = nx; }
        const unsigned old = xb_add(&bar[XB_XSUB(b.x)], 1u);
        const unsigned gen = old / nloc;
        if (old + 1u == (gen + 1u) * nloc) {
            __builtin_amdgcn_fence(__ATOMIC_RELEASE, "agent");
            asm volatile("s_waitcnt vmcnt(0)" ::: "memory");
            const unsigned og = xb_add(&bar[XB_TOP], 1u);
            const unsigned tg = og / nx;
            if (og + 1u == (tg + 1u) * nx) xb_add(&bar[XB_TOPGEN], 1u);
            else XB_SPIN(xb_ld(&bar[XB_TOPGEN]) == tg, bar);
            __builtin_amdgcn_fence(__ATOMIC_ACQUIRE, "agent");
            xb_add(&bar[XB_XGEN(b.x)], 1u);
            asm volatile("s_waitcnt vmcnt(0)" ::: "memory");
        } else {
            XB_SPIN(xb_ld(&bar[XB_XGEN(b.x)]) == gen, bar);
            __builtin_amdgcn_fence(__ATOMIC_ACQUIRE, "agent");
            asm volatile("s_waitcnt vmcnt(0)" ::: "memory");
        }
    }
    __syncthreads();
}

__constant__ __attribute__((aligned(16))) float INV_FREQ[32] = {
    1.0f, 0.7498942093324559f, 0.5623413251903491f, 0.4216965034285822f, 0.31622776601683794f, 0.23713737056616552f, 0.1778279410038923f, 0.1333521432163324f,
    0.1f, 0.07498942093324558f, 0.05623413251903491f, 0.04216965034285822f, 0.03162277660168379f, 0.023713737056616554f, 0.01778279410038923f, 0.01333521432163324f,
    0.01f, 0.007498942093324558f, 0.005623413251903491f, 0.004216965034285822f, 0.0031622776601683794f, 0.0023713737056616554f, 0.001778279410038923f, 0.001333521432163324f,
    0.001f, 0.0007498942093324559f, 0.0005623413251903491f, 0.0004216965034285822f, 0.00031622776601683794f, 0.00023713737056616554f, 0.0001778279410038923f, 0.0001333521432163324f};

__device__ __forceinline__ void transpose_item(const float* W, int N, bf16_t* WT, int Kd, int k0, int n0, int drow0, LAS float* scr, int lane) {
    {
        const int kr = lane >> 3, n4 = (lane & 7) * 4; f32x4 v[8];
#pragma unroll
        for (int i = 0; i < 8; ++i) v[i] = __builtin_nontemporal_load((const f32x4*)(W + (size_t)(k0 + 8 * i + kr) * N + n0 + n4));
#pragma unroll
        for (int i = 0; i < 8; ++i) { LAS float* d = scr + (8 * i + kr) * 33 + n4; d[0] = v[i].x; d[1] = v[i].y; d[2] = v[i].z; d[3] = v[i].w; }
    }
    LDS_WAIT(); asm volatile("" ::: "memory");
    const int c = lane & 7;
#pragma unroll
    for (int j = 0; j < 4; ++j) { const int n = (lane >> 3) + 8 * j; const LAS float* s = scr + (8 * c) * 33 + n;
        u32x4 o; o.x = cvtpk(s[0 * 33], s[1 * 33]); o.y = cvtpk(s[2 * 33], s[3 * 33]); o.z = cvtpk(s[4 * 33], s[5 * 33]); o.w = cvtpk(s[6 * 33], s[7 * 33]);
        __builtin_nontemporal_store(o, (GAS u32x4*)(WT + (size_t)(drow0 + n) * Kd + k0 + 8 * c)); }
    LDS_WAIT(); asm volatile("" ::: "memory");
}

struct Pend { const float* slab; int S; const float* gate; const float* bias; float mul; };
__device__ __forceinline__ void load_x_row(const void* xrow, bool xbf, int lane, f32x4 (&h)[8], const Pend& pd) {
    if (xbf) {
#pragma unroll
        for (int j = 0; j < 8; ++j) { const u32x2 w = ((const u32x2*)xrow)[lane + 64 * j];
            h[j] = (f32x4){bf2f((unsigned short)(w.x & 0xffffu)), bf2f((unsigned short)(w.x >> 16)), bf2f((unsigned short)(w.y & 0xffffu)), bf2f((unsigned short)(w.y >> 16))}; }
    } else {
#pragma unroll
        for (int j = 0; j < 8; ++j) h[j] = ((const f32x4*)xrow)[lane + 64 * j];
    }
    if (pd.slab) {
        f32x4 a[8];
#pragma unroll
        for (int j = 0; j < 8; ++j) a[j] = pd.bias ? ((const f32x4*)pd.bias)[lane + 64 * j] : (f32x4){0.f, 0.f, 0.f, 0.f};
        if (pd.S == 0) {
#pragma unroll
            for (int j = 0; j < 8; ++j) { const u32x2 w = ((const u32x2*)pd.slab)[lane + 64 * j];
                a[j] = a[j] + (f32x4){bf2f((unsigned short)(w.x & 0xffffu)), bf2f((unsigned short)(w.x >> 16)), bf2f((unsigned short)(w.y & 0xffffu)), bf2f((unsigned short)(w.y >> 16))}; }
        } else {
#pragma unroll 2
            for (int s = 0; s < pd.S; ++s) { f32x4 t[8];
#pragma unroll
                for (int j = 0; j < 8; ++j) t[j] = bf4(((const u32x2*)((const bf16_t*)pd.slab + (size_t)s * ((size_t)NSR * D)))[lane + 64 * j]);
#pragma unroll
                for (int j = 0; j < 8; ++j) a[j] = a[j] + t[j]; }
        }
#pragma unroll
        for (int j = 0; j < 8; ++j) h[j] = h[j] + (((const f32x4*)pd.gate)[lane + 64 * j] * pd.mul) * a[j];
    }
}
__device__ __forceinline__ void norm_mod_row(const void* xrow, bool xbf, const float* g, const float* shift, const float* scale, int lane, f32x4 (&h)[8], bf16_t* xcopy, const Pend& pd) {
    float ss = 0.f;
    load_x_row(xrow, xbf, lane, h, pd);
#pragma unroll
    for (int j = 0; j < 8; ++j) ss += (h[j].x * h[j].x + h[j].y * h[j].y) + (h[j].z * h[j].z + h[j].w * h[j].w);
    if (xcopy) {
#pragma unroll
        for (int j = 0; j < 8; ++j) { u32x2 w; w.x = cvtpk(h[j].x, h[j].y); w.y = cvtpk(h[j].z, h[j].w); __builtin_nontemporal_store(w, (u32x2*)xcopy + lane + 64 * j); }
    }
    ss = wave_sum(ss);
    const float rs = 1.0f / sqrtf(ss * (1.0f / D) + RMS_EPS);
#pragma unroll
    for (int j = 0; j < 8; ++j) { const f32x4 g4 = ((const f32x4*)g)[lane + 64 * j], sc = ((const f32x4*)scale)[lane + 64 * j], sh = ((const f32x4*)shift)[lane + 64 * j];
        h[j] = (h[j] * rs * g4) * (1.0f + sc) + sh; }
}
__device__ __forceinline__ void store_bf16_row(bf16_t* orow, const f32x4 (&h)[8], int lane) {
#pragma unroll
    for (int j = 0; j < 8; ++j) { u32x2 w; w.x = cvtpk(h[j].x, h[j].y); w.y = cvtpk(h[j].z, h[j].w); __builtin_nontemporal_store(w, (u32x2*)orow + lane + 64 * j); }
}

__device__ __forceinline__ void scan_step(f32x4& S, const f32x4 w, const f32x4 kk, const f32x4 kka, const f32x4 kp, const f32x4 r, const float vv, float& y) {
    float p = S.x * kk.x; p = fmaf(S.y, kk.y, p); p = fmaf(S.z, kk.z, p); p = fmaf(S.w, kk.w, p);
    p = row16_sum(p);
    S.x = fmaf(S.x, w.x, fmaf(-p, kka.x, vv * kp.x)); S.y = fmaf(S.y, w.y, fmaf(-p, kka.y, vv * kp.y));
    S.z = fmaf(S.z, w.z, fmaf(-p, kka.z, vv * kp.z)); S.w = fmaf(S.w, w.w, fmaf(-p, kka.w, vv * kp.w));
    float q = S.x * r.x; q = fmaf(S.y, r.y, q); q = fmaf(S.z, r.z, q); q = fmaf(S.w, r.w, q);
    y = row16_sum(q);
}
__device__ __forceinline__ void rwkv_derive(const f32x4 k4, const f32x4 a4, const f32x4 kkw, const f32x4 kaw, f32x4& kk, f32x4& kka, f32x4& kp) {
    kk = k4 * kkw; float ss = (kk.x * kk.x + kk.y * kk.y) + (kk.z * kk.z + kk.w * kk.w); ss = row16_sum(ss);
    const float inv = __builtin_amdgcn_rsqf(fmaxf(ss, 1e-24f));
    kk = kk * inv; kka = kk * a4; kp = k4 * (1.0f + (a4 - 1.0f) * kaw);
}

struct Args { const float* in[35]; float* out; unsigned char* ws; int ph_lo, ph_hi; };

#define x_prompt (ap->in[0])
#define x_sample (ap->in[1])
#define st_wkv (ap->in[2])
#define st_shift (ap->in[3])
#define cache_k (ap->in[4])
#define cache_v (ap->in[5])
#define c_prompt (ap->in[6])
#define c_sample (ap->in[7])
#define norm_g (ap->in[8])
#define w_ada (ap->in[9])
#define b_ada (ap->in[10])
#define w_ffn_in (ap->in[11])
#define w_ffn_out (ap->in[12])
#define rw_mu (ap->in[13])
#define rw_wrkv (ap->in[14])
#define rw_w0 (ap->in[15])
#define rw_w1 (ap->in[16])
#define rw_w2 (ap->in[17])
#define rw_a0 (ap->in[18])
#define rw_a1 (ap->in[19])
#define rw_a2 (ap->in[20])
#define rw_g1 (ap->in[21])
#define rw_g2 (ap->in[22])
#define rw_kk (ap->in[23])
#define rw_ka (ap->in[24])
#define rw_rk (ap->in[25])
#define rw_gn_w (ap->in[26])
#define rw_gn_b (ap->in[27])
#define rw_wo (ap->in[28])
#define sw_wqkv (ap->in[29])
#define sw_bqkv (ap->in[30])
#define sw_sink (ap->in[31])
#define sw_wo (ap->in[32])
#define sw_bo (ap->in[33])
#define final_g (ap->in[34])
#define W_ADA ((bf16_t*)(ap->ws + WS_WADA))
#define W_FIN ((bf16_t*)(ap->ws + WS_WFIN))
#define W_FOUT ((bf16_t*)(ap->ws + WS_WFOUT))
#define W_RKVL1 ((bf16_t*)(ap->ws + WS_WRKVL1))
#define W_L2 ((bf16_t*)(ap->ws + WS_WL2))
#define W_RWO ((bf16_t*)(ap->ws + WS_WRWO))
#define W_QKV ((bf16_t*)(ap->ws + WS_WQKV))
#define W_SWO ((bf16_t*)(ap->ws + WS_WSWO))
#define CS ((bf16_t*)(ap->ws + WS_CS))
#define MOD ((float*)(ap->ws + WS_MOD))
#define X ((float*)(ap->ws + WS_X))
#define HA ((bf16_t*)(ap->ws + WS_HA))
#define ACT ((bf16_t*)(ap->ws + WS_ACT))
#define XA6 ((bf16_t*)(ap->ws + WS_XA6))
#define DAG ((float*)(ap->ws + WS_DAG))
#define RKV ((float*)(ap->ws + WS_RKV))
#define L1OUT ((bf16_t*)(ap->ws + WS_L1OUT))
#define YRAW ((float*)(ap->ws + WS_YRAW))
#define QKV ((float*)(ap->ws + WS_QKV))
#define QB ((bf16_t*)(ap->ws + WS_QB))
#define KB ((bf16_t*)(ap->ws + WS_KB))
#define VB ((bf16_t*)(ap->ws + WS_VB))
#define SLAB ((float*)(ap->ws + WS_SLAB))
#define DELTA ((float*)(ap->ws + WS_DELTA))
#define XBUF(i_) ((bf16_t*)(ap->ws + ((i_) ? WS_X2 : WS_X)))
#define out (ap->out)
#define BONUS ((float*)(ap->ws + WS_L1OUT))

#define MAKE_PEND(pd_, m_, b_, S_, modl_, slot_, bias_, mul_) do { pd_.slab = (m_) < NPR ? (const float*)((const bf16_t*)DELTA + (size_t)(m_) * D) : (const float*)((const bf16_t*)SLAB + (size_t)((m_) - NPR) * D); pd_.S = (m_) < NPR ? 0 : (S_); \
    pd_.gate = MOD + (size_t)(modl_) * NCB * NMOD * D + (size_t)(b_) * NMOD * D + (size_t)(slot_) * D; pd_.bias = (bias_); pd_.mul = (mul_); } while (0)
typedef const __attribute__((address_space(4))) Args* ArgsP;
__global__ void __launch_bounds__(NTHREADS, 2) mk_fwd(Args args) {
    extern __shared__ __attribute__((aligned(16))) unsigned char lds_raw[];
    LAS unsigned char* lds0 = (LAS unsigned char*)lds_raw;
    volatile LAS unsigned* MISC = (volatile LAS unsigned*)(lds0 + MISC_OFF);
    for (int u = threadIdx.x; u < (LDS_BYTES - LDSCTL_OFF) / 4; u += NTHREADS) ((LAS unsigned*)(lds0 + LDSCTL_OFF))[u] = 0u;
    __syncthreads();
    (void)xcd_barrier_post((unsigned*)(args.ws + WS_CTL) + CW_BAR, MISC + 8);
#define PH_SETUP ArgsP ap; { ArgsP p_ = (ArgsP)__builtin_amdgcn_kernarg_segment_ptr(); asm volatile("" : "+s"(p_)); ap = p_; } \
    int tid = threadIdx.x; asm volatile("" : "+v"(tid)); const int lane = tid & 63, wave = __builtin_amdgcn_readfirstlane(tid >> 6); \
    int G = gridDim.x; asm volatile("" : "+s"(G)); int bx = blockIdx.x; asm volatile("" : "+s"(bx)); const int vcu = (G % 8 == 0) ? (bx % 8) * (G / 8) + bx / 8 : bx; const int gw = vcu * NWAVES + wave, NGW = G * NWAVES; \
    unsigned ldsz_ = 0u; asm volatile("" : "+s"(ldsz_)); LAS unsigned char* lds = lds0 + ldsz_; \
    (void)lane; (void)gw; (void)NGW; (void)vcu; (void)lds;
#define PH_BARRIER do { XcdBarrier b_; { ArgsP p_ = (ArgsP)__builtin_amdgcn_kernarg_segment_ptr(); asm volatile("" : "+s"(p_)); b_.bar = (unsigned*)(p_->ws + WS_CTL) + CW_BAR; } b_.x = xb_xcc_id(); b_.st = MISC + 8; xcd_barrier(b_); } while (0)
#if MK_PER_PHASE
    const int lo = args.ph_lo, hi = args.ph_hi; int pc = 0;
#define PH_BEGIN if (pc >= lo && pc < hi) { PH_SETUP
#define PH_END } ++pc;
#else
#define PH_BEGIN { PH_SETUP
#define PH_END } PH_BARRIER;
#endif
#define PH_END_LAST }

#define QPOP(it_) do { unsigned q_ = 0u; if (lane == 0) q_ = __hip_atomic_fetch_add(qc, 1u, __ATOMIC_RELAXED, __HIP_MEMORY_SCOPE_WORKGROUP); it_ = (int)__builtin_amdgcn_readfirstlane(q_); } while (0)
#define QROWS_SETUP LAS unsigned* qc = (LAS unsigned*)(lds + QCTR_OFF) + qslot; const int qs0 = (vcu * NSR) / G, qns = ((vcu + 1) * NSR) / G - qs0, qnit = qns + NWAVES * ((NPR + NGW - 1) / NGW);
#define QROW(it_) ((it_) < qns ? NPR + qs0 + (it_) : NWAVES * vcu + (((it_) - qns) & (NWAVES - 1)) + NGW * (((it_) - qns) / NWAVES))
#define QSKIP(it_, m_) ((it_) >= qns && (m_) >= NPR)
    int qslot = 0;
    int xcur = 0;
    PH_BEGIN
    {
        LAS float* scr = (LAS float*)(lds + wave * 16384);
        for (int jobi = 0; jobi < 16; ++jobi) { const int job = (jobi + 2) & 15;
            if (G == 256 && (job == 9 || job == 14 || job == 15)) continue;
            const float* W; int K_, N_; bf16_t* WT; int mode = 0, roff = 0;
            if (job < 2) { W = w_ada + (size_t)job * D * 18432; K_ = D; N_ = 18432; WT = W_ADA; roff = job * 18432; }
            else if (job < 6) { W = w_ffn_in + (size_t)(job - 2) * D * (2 * FF); K_ = D; N_ = 2 * FF; WT = W_FIN + (size_t)(job - 2) * (2 * FF) * D; mode = 1; }
            else if (job < 10) { W = w_ffn_out + (size_t)(job - 6) * FF * D; K_ = FF; N_ = D; WT = W_FOUT + (size_t)(job - 6) * D * FF; }
            else if (job < 13) { W = rw_wrkv + (size_t)(job - 10) * D * D; K_ = D; N_ = D; WT = W_RKVL1; roff = (job - 10) * D; }
            else if (job == 13) { W = rw_wo; K_ = D; N_ = D; WT = W_RWO; }
            else if (job == 14) { W = sw_wqkv; K_ = D; N_ = QKVW; WT = W_QKV; }
            else { W = sw_wo; K_ = D; N_ = D; WT = W_SWO; }
            const int nblk = N_ / 32, nitems = (K_ / 64) * nblk;
            for (int it = gw; it < nitems; it += NGW) { const int kb = it / nblk, nb = it % nblk, n0 = 32 * nb;
                int drow0 = roff + n0;
                if (mode == 1) { const int up = n0 >= FF ? 1 : 0, jj = n0 - up * FF; drow0 = 256 * (jj >> 7) + 128 * up + (jj & 127); }
                transpose_item(W, N_, WT, K_, 64 * kb, n0, drow0, scr, lane); }
        }
        const int gt = gw * 64 + lane, NGT = NGW * 64;
        for (int idx = gt; idx < 768 * 2048; idx += NGT) { const int n = idx >> 11, k = idx & 2047, i = n >> 8, nn = n & 255;
            const float* src = i == 0 ? rw_w1 : i == 1 ? rw_a1 : rw_g1; const int Ni = i == 2 ? 256 : 96;
            const float v = nn < Ni ? src[(size_t)k * Ni + nn] : 0.f; W_RKVL1[(size_t)(6144 + n) * D + k] = (bf16_t)(cvtpk(v, 0.f) & 0xffffu); }
        for (int idx = gt; idx < 6144 * 256; idx += NGT) { const int n = idx >> 8, k = idx & 255, i = n >> 11, nn = n & 2047;
            const float* src = i == 0 ? rw_w2 : i == 1 ? rw_a2 : rw_g2; const int Ki = i == 2 ? 256 : 96;
            const float v = k < Ki ? src[(size_t)k * D + nn] : 0.f; W_L2[(size_t)n * 256 + k] = (bf16_t)(cvtpk(v, 0.f) & 0xffffu); }
        for (int idx = gt; idx < 256 * D; idx += NGT) { const int r = idx >> 11, k = idx & 2047;
            float v = 0.f; if (r < 2) v = siluf_(c_prompt[r * D + k]); else if (r < NCB) v = siluf_(c_sample[(r - 2) * D + k]);
            CS[idx] = (bf16_t)(cvtpk(v, 0.f) & 0xffffu); }
    }
    PH_END

    PH_BEGIN
    {
        pg8::Sched<pg8::ASel0, pg8::SplitOrder<1, 144, 32, 1, 1>> S; S.ord.init(G, bx); S.A = (const char*)CS; S.Bt = (const char*)W_ADA; S.tstep = (size_t)256 * D * 2; S.astride = 0;
        pg8::EpiAda E{MOD, b_ada};
        pg8::gemm_phase(lds, tid, D, S, E);
        if (G == 256 && bx >= 144) {
            LAS float* scr = (LAS float*)(lds + wave * 16384);
            const int gwi = (bx - 144) * NWAVES + wave, NGI = (256 - 144) * NWAVES;
            for (int jq = 0; jq < 3; ++jq) {
                const float* W; int K_, N_; bf16_t* WT;
                if (jq == 0) { W = w_ffn_out + (size_t)3 * FF * D; K_ = FF; N_ = D; WT = W_FOUT + (size_t)3 * D * FF; }
                else if (jq == 1) { W = sw_wqkv; K_ = D; N_ = QKVW; WT = W_QKV; }
                else { W = sw_wo; K_ = D; N_ = D; WT = W_SWO; }
                const int nblk = N_ / 32, nitems = (K_ / 64) * nblk;
                for (int it = gwi; it < nitems; it += NGI) { const int kb = it / nblk, nb = it % nblk, n0 = 32 * nb;
                    transpose_item(W, N_, WT, K_, 64 * kb, n0, n0, scr, lane); }
            }
        }
    }
    PH_END

    for (int layer = 0; layer < 2; ++layer) {
        for (int sub = 0; sub < 3; ++sub) {
            if (sub != 1) {
                const int fi = layer * 2 + (sub >> 1);
                PH_BEGIN
                {
                    const bool first = (layer == 0 && sub == 0);
                    QROWS_SETUP
                    for (;;) { int it; QPOP(it); if (it >= qnit) break; const int m = QROW(it); if (QSKIP(it, m)) continue; const int b = bidx_of_row(m);
                        const void* xrow = first ? (const void*)(m < NPR ? x_prompt + (size_t)m * D : x_sample + (size_t)(m - NPR) * D) : (const void*)(XBUF(xcur) + (size_t)m * D);
                        const float* mb = (MOD + (size_t)layer * NCB * NMOD * D) + (size_t)b * NMOD * D + (size_t)(3 * sub) * D;
                        Pend pd{nullptr, 0, nullptr, nullptr, 0.f};
                        if (!first) { if (sub == 0) MAKE_PEND(pd, m, b, 11, layer - 1, 8, nullptr, 0.5f); else MAKE_PEND(pd, m, b, 8, layer, 5, (layer == 0 ? nullptr : sw_bo), 1.0f); }
                        f32x4 h[8]; if (first) norm_mod_row(xrow, false, (norm_g + (size_t)(layer * 3 + sub) * D), mb, mb + D, lane, h, XBUF(xcur) + (size_t)m * D, pd); else norm_mod_row(xrow, true, (norm_g + (size_t)(layer * 3 + sub) * D), mb, mb + D, lane, h, XBUF(xcur ^ 1) + (size_t)m * D, pd);
                        store_bf16_row(HA + (size_t)m * D, h, lane); }
                }
                PH_END
                ++qslot;
                if (!(layer == 0 && sub == 0)) xcur ^= 1;
                PH_BEGIN
                {
                    pg8::Sched<pg8::ASel0, pg8::SplitOrder<34, 44, 32, 34, 1>> S; S.ord.init(G, bx); S.A = (const char*)HA; S.Bt = (const char*)(W_FIN + (size_t)fi * (2 * FF) * D); S.tstep = (size_t)256 * D * 2; S.astride = 0;
                    pg8::EpiSwiglu E{ACT};
                    pg8::gemm_phase(lds, tid, D, S, E);
                }
                PH_END
                PH_BEGIN
                {
                    pg8::Sched<pg8::ASel0, pg8::SplitOrder<34, 8, 88, 32, 11>> S; S.ord.init(G, bx); S.A = (const char*)ACT; S.Bt = (const char*)(W_FOUT + (size_t)fi * D * FF); S.tstep = (size_t)256 * FF * 2; S.astride = 0;
                    pg8::EpiDelta E{(bf16_t*)DELTA, SLAB};
                    pg8::gemm_phase(lds, tid, FF, S, E);
                }
                PH_END
            } else if (layer == 0) {
                PH_BEGIN
                {
                    LAS unsigned* qc = (LAS unsigned*)(lds + QCTR_OFF) + qslot;
                    const int wg = (G == 256) ? 12 : 0, g0 = (vcu * 128) / G, g1 = ((vcu + 1) * 128) / G, nsg = g1 - g0;
                    const int p0 = wg ? 38 * vcu - wg * g0 : (vcu * NPR) / G, p1 = wg ? 38 * (vcu + 1) - wg * g1 : ((vcu + 1) * NPR) / G;
                    const int wav = (NWAVES - nsg) > 1 ? (NWAVES - nsg) : 1, chunk = ((p1 - p0) + wav - 1) / wav > 1 ? ((p1 - p0) + wav - 1) / wav : 1, nitq = nsg + ((p1 - p0) + chunk - 1) / chunk;
                    for (;;) { int it; QPOP(it); if (it >= nitq) break;
                        int m0, n, t0, sidx = 0; if (it >= nsg) { m0 = p0 + chunk * (it - nsg); n = (p1 - m0) < chunk ? (p1 - m0) : chunk; t0 = m0 & 4095; } else { sidx = g0 + it; m0 = NPR + 4 * sidx; n = 4; t0 = 0; }
                        const int b = bidx_of_row(m0); const float* mb = (MOD + (size_t)layer * NCB * NMOD * D) + (size_t)b * NMOD * D + 3 * D;
                        f32x4 prev[8], h[8];
                        if (t0 == 0) {
                            if (m0 < NPR) {
#pragma unroll
                                for (int j = 0; j < 8; ++j) prev[j] = (f32x4){0.f, 0.f, 0.f, 0.f};
                            } else {
#pragma unroll
                                for (int j = 0; j < 8; ++j) prev[j] = ((const f32x4*)(st_shift + (size_t)sidx * D))[lane + 64 * j];
                            }
                        } else { Pend pd0{nullptr, 0, nullptr, nullptr, 0.f}; MAKE_PEND(pd0, m0 - 1, b, 11, layer, 2, nullptr, 0.5f); norm_mod_row(XBUF(xcur) + (size_t)(m0 - 1) * D, true, (norm_g + (size_t)(layer * 3 + sub) * D), mb, mb + D, lane, prev, nullptr, pd0); }
                        for (int r = 0; r < n; ++r) { const int m = m0 + r;
                            if (G != 256 && r > 0 && m < NPR && (m & 4095) == 0) {
#pragma unroll
                                for (int j = 0; j < 8; ++j) prev[j] = (f32x4){0.f, 0.f, 0.f, 0.f}; }
                            const int bm = bidx_of_row(m); const float* mbm = (MOD + (size_t)layer * NCB * NMOD * D) + (size_t)bm * NMOD * D + 3 * D;
                            Pend pd{nullptr, 0, nullptr, nullptr, 0.f}; MAKE_PEND(pd, m, bm, 11, layer, 2, nullptr, 0.5f);
                            norm_mod_row(XBUF(xcur) + (size_t)m * D, true, (norm_g + (size_t)(layer * 3 + sub) * D), mbm, mbm + D, lane, h, XBUF(xcur ^ 1) + (size_t)m * D, pd);
#pragma unroll 1
                            for (int i = 0; i < 6; ++i) { bf16_t* orow = XA6 + (size_t)i * M * D + (size_t)m * D; const int mi = (i == 1) ? 2 : (i == 2) ? 3 : (i == 3) ? 1 : i;
#pragma unroll
                                for (int j = 0; j < 8; ++j) { const f32x4 mu = ((const f32x4*)(rw_mu + mi * D))[lane + 64 * j]; const f32x4 v = h[j] + (prev[j] - h[j]) * mu;
                                    u32x2 w; w.x = cvtpk(v.x, v.y); w.y = cvtpk(v.z, v.w); __builtin_nontemporal_store(w, (u32x2*)orow + lane + 64 * j); } }
                            const bool lastp = (m < NPR) && ((m & 4095) == 4095), lasts = (m >= NPR) && (r == 3);
                            if (lastp || lasts) { float* so = lastp ? out + O_PSHIFT + (size_t)bm * D : out + O_SSHIFT + (size_t)sidx * D;
#pragma unroll
                                for (int j = 0; j < 8; ++j) ((f32x4*)so)[lane + 64 * j] = h[j]; }
#pragma unroll
                            for (int j = 0; j < 8; ++j) prev[j] = h[j];
                        }
                    }
                }
                PH_END
                ++qslot;
                xcur ^= 1;
                PH_BEGIN
                {
                    pg8::Sched<pg8::ASelRKV, pg8::SplitOrder<34, 27, 32, 34, 1>> S; S.ord.init(G, bx); S.A = (const char*)XA6; S.Bt = (const char*)W_RKVL1; S.tstep = (size_t)256 * D * 2; S.astride = (size_t)M * D * 2;
                    pg8::EpiRKV E{RKV, L1OUT};
                    pg8::gemm_phase(lds, tid, D, S, E);
                }
                PH_END
                PH_BEGIN
                {
                    pg8::Sched<pg8::ASelL2, pg8::SplitOrder<34, 24, 4, 34, 1>> S; S.ord.init(G, bx); S.A = (const char*)L1OUT; S.Bt = (const char*)W_L2; S.tstep = (size_t)256 * 256 * 2; S.astride = (size_t)M * 256 * 2;
                    pg8::EpiL2 E{DAG, rw_w0, rw_a0};
                    pg8::gemm_phase(lds, tid, 256, S, E);
                }
                PH_END
                PH_BEGIN
                {
                    const float* Rr = RKV; const float* Kk = RKV + D; const float* Vv = RKV + 2 * D;
                    const float* Dec = DAG; const float* Aa = DAG + (size_t)M * D;
                    const int rg = lane >> 4, kq = lane & 15;
#define SAMPLE_TASK(task_) do { const int stk_ = (task_); \
                        const int bs = stk_ >> 9, hs_ = (stk_ >> 4) & 31, rq = stk_ & 15, srow = 4 * rq + rg, scol = hs_ * 64 + 4 * kq; \
                        const f32x4 kkw_ = *(const f32x4*)(rw_kk + scol), kaw_ = *(const f32x4*)(rw_ka + scol); \
                        const size_t so = (((size_t)bs * NH + hs_) * 64 + srow) * 64 + 4 * kq; \
                        f32x4 Ss = *(const f32x4*)(st_wkv + so); \
                        _Pragma("unroll") for (int t = 0; t < DEC_T; ++t) { const size_t o = ((size_t)NPR + 4 * bs + t) * D + scol, o2 = ((size_t)NPR + 4 * bs + t) * LDR + scol; \
                            const f32x4 k4 = *(const f32x4*)(Kk + o2), a4 = *(const f32x4*)(Aa + o), w4 = *(const f32x4*)(Dec + o), r4 = *(const f32x4*)(Rr + o2); \
                            const float vv = Vv[((size_t)NPR + 4 * bs + t) * LDR + hs_ * 64 + srow]; \
                            f32x4 kk, kka, kp; rwkv_derive(k4, a4, kkw_, kaw_, kk, kka, kp); float y; \
                            scan_step(Ss, w4, kk, kka, kp, r4, vv, y); \
                            if (kq == 0) YRAW[((size_t)NPR + 4 * bs + t) * D + hs_ * 64 + srow] = y; } \
                        *(f32x4*)(out + O_SWKV + so) = Ss; } while (0)
#define SAMPLE_ISSUE(task_) do { const int stk_ = (task_); sp_bs = stk_ >> 9; sp_h = (stk_ >> 4) & 31; sp_row = 4 * (stk_ & 15) + rg; const int scol = sp_h * 64 + 4 * kq; \
                        sp_so = (((size_t)sp_bs * NH + sp_h) * 64 + sp_row) * 64 + 4 * kq; sp_S = *(const f32x4*)(st_wkv + sp_so); sp_kkw = *(const f32x4*)(rw_kk + scol); sp_kaw = *(const f32x4*)(rw_ka + scol); \
                        _Pragma("unroll") for (int t = 0; t < DEC_T; ++t) { const size_t o = ((size_t)NPR + 4 * sp_bs + t) * D + scol, o2 = ((size_t)NPR + 4 * sp_bs + t) * LDR + scol; \
                            sp_k[t] = *(const f32x4*)(Kk + o2); sp_a[t] = *(const f32x4*)(Aa + o); sp_w[t] = *(const f32x4*)(Dec + o); sp_r[t] = *(const f32x4*)(Rr + o2); \
                            sp_v[t] = Vv[((size_t)NPR + 4 * sp_bs + t) * LDR + sp_h * 64 + sp_row]; } sp_pending = true; } while (0)
#define SAMPLE_FINISH() do { if (sp_pending) { \
                        _Pragma("unroll") for (int t = 0; t < DEC_T; ++t) { f32x4 kk, kka, kp; rwkv_derive(sp_k[t], sp_a[t], sp_kkw, sp_kaw, kk, kka, kp); float y; \
                            scan_step(sp_S, sp_w[t], kk, kka, kp, sp_r[t], sp_v[t], y); \
                            if (kq == 0) YRAW[((size_t)NPR + 4 * sp_bs + t) * D + sp_h * 64 + sp_row] = y; } \
                        *(f32x4*)(out + O_SWKV + sp_so) = sp_S; sp_pending = false; } } while (0)
                    constexpr int CH = 16, NCH = SEQ / CH;
                    constexpr int SLOTB = 16384, O_KT = 0, O_RT = 2304, O_BT = 4608, O_KL = 6912, O_KH = 9216, O_BH = 11264, O_VT = 13312, O_GAM = 13824, O_AKK = 14080, O_AKR = 14592, O_ABR = 15104, O_ABK = 15616, O_DG = 16128;
#define BF1(x_) ((unsigned short)(cvtpk((x_), 0.f) & 0xffffu))
#define STEP_BARRIER() asm volatile("s_waitcnt lgkmcnt(0)\n\ts_barrier" ::: "memory")
                    for (int task = vcu; task < 256; task += G) {
                        const int bh = task >> 2, cq = task & 3, b = bh >> 5, hh = bh & 31;
                        const size_t rowbase = (size_t)b * SEQ;
                        if (wave >= 4) {
                            const int lw = wave - 4, t = lane >> 2, kq4 = lane & 3, kc = 16 * lw + 4 * kq4, col = hh * 64 + kc, rho = lane >> 4;
                            const f32x4 kkw_o = *(const f32x4*)(rw_kk + col), kaw_o = *(const f32x4*)(rw_ka + col);
                            LAS float* ssq = (LAS float*)(lds + 3 * SLOTB + 4096);
                            f32x4 Lk[4], La[4], Lw[4], Lr[4], Lv[4];
#define L_ISSUE(c_, q_) do { const size_t mrow = rowbase + (size_t)(c_) * CH + t; const size_t o = mrow * D + col, o2 = mrow * LDR + col; \
                                Lk[q_] = *(const f32x4*)(Kk + o2); La[q_] = *(const f32x4*)(Aa + o); Lw[q_] = *(const f32x4*)(Dec + o); Lr[q_] = *(const f32x4*)(Rr + o2); \
                                Lv[q_] = *(const f32x4*)(Vv + mrow * LDR + hh * 64 + 16 * cq + 4 * kq4); } while (0)
#define L_PROC(c_, q_) do { LAS unsigned char* SB = lds + ((c_) % 3) * SLOTB; \
                                const f32x4 kk = Lk[q_] * kkw_o, kka = kk * La[q_], kp = Lk[q_] * (1.0f + (La[q_] - 1.0f) * kaw_o);     \
                                { float ss = (kk.x * kk.x + kk.y * kk.y) + (kk.z * kk.z + kk.w * kk.w); ss += dppf<0xB1>(ss); ss += dppf<0x4E>(ss); if (kq4 == 0) ssq[((c_) % 3) * 64 + lw * 16 + t] = ss; } \
                                f32x4 P; _Pragma("unroll") for (int e = 0; e < 4; ++e) { float p = Lw[q_][e]; p *= dppm<0x114>(p); p *= dppm<0x118>(p); P[e] = p; }     \
                                f32x4 gam, e1, e2, e3, e4; \
                                { LAS f32x4* scr = (LAS f32x4*)(lds + 3 * SLOTB + lw * 1024); scr[lane] = P;                    \
                                  const f32x4 T0 = scr[12 + kq4], T1 = scr[28 + kq4], T2 = scr[44 + kq4], T3 = scr[60 + kq4]; \
                                  const f32x4 one4 = (f32x4){1.f, 1.f, 1.f, 1.f}; \
                                  e2 = P * ((rho >= 1 ? T0 : one4) * (rho >= 2 ? T1 : one4)) * (rho >= 3 ? T2 : one4);          \
                                  gam = (T0 * T1) * (T2 * T3); }                                                               \
                                _Pragma("unroll") for (int e = 0; e < 4; ++e) { e3[e] = frcp(e2[e]); e1[e] = e2[e] * frcp(Lw[q_][e]); } e4 = gam * e3;     \
                                const f32x4 kt = kk * e1, rt = Lr[q_] * e2, bt = kka * e3, kl = kp * e3, Bh = kka * e4, Kh = kp * e4; \
                                const int roff = t * 144 + ((lw >> 1) * 4 + kq4) * 16 + (lw & 1) * 8; \
                                { u32x2 w_; w_.x = cvtpk(kt.x, kt.y); w_.y = cvtpk(kt.z, kt.w); *(LAS u32x2*)(SB + O_KT + roff) = w_; w_.x = cvtpk(rt.x, rt.y); w_.y = cvtpk(rt.z, rt.w); *(LAS u32x2*)(SB + O_RT + roff) = w_; \
                                  w_.x = cvtpk(bt.x, bt.y); w_.y = cvtpk(bt.z, bt.w); *(LAS u32x2*)(SB + O_BT + roff) = w_; w_.x = cvtpk(kl.x, kl.y); w_.y = cvtpk(kl.z, kl.w); *(LAS u32x2*)(SB + O_KL + roff) = w_; } \
                                const int toff = (t >> 2) * 8 + (t & 3) * 2; \
                                _Pragma("unroll") for (int e = 0; e < 4; ++e) { *(LAS unsigned short*)(SB + O_KH + (kc + e) * 32 + toff) = BF1(Kh[e]); *(LAS unsigned short*)(SB + O_BH + (kc + e) * 32 + toff) = BF1(Bh[e]); } \
                                if (lw == 0) { _Pragma("unroll") for (int e = 0; e < 4; ++e) *(LAS unsigned short*)(SB + O_VT + (4 * kq4 + e) * 32 + toff) = BF1(Lv[q_][e]); } \
                                if (t == 15) *(LAS f32x4*)(SB + O_GAM + kc * 4) = gam; } while (0)
                            L_ISSUE(0, 0); L_ISSUE(1, 1); L_ISSUE(2, 2); L_ISSUE(3, 3);
                            for (int s0 = 0; s0 < NCH - 4; s0 += 4) {
#pragma unroll
                                for (int q = 0; q < 4; ++q) { const int s = s0 + q;
                                    L_PROC(s, q); L_ISSUE(s + 4, q); STEP_BARRIER(); }
                            }
                            L_PROC(NCH - 4, 0); STEP_BARRIER(); L_PROC(NCH - 3, 1); STEP_BARRIER(); L_PROC(NCH - 2, 2); STEP_BARRIER(); L_PROC(NCH - 1, 3); STEP_BARRIER();
                            STEP_BARRIER(); STEP_BARRIER();
#undef L_ISSUE
#undef L_PROC
                        } else if (wave == 1) {
                            const int r16 = lane & 15, g = lane >> 4;
                            f32x4 rkw[2][2];
#pragma unroll
                            for (int h2 = 0; h2 < 2; ++h2)
#pragma unroll
                                for (int hf = 0; hf < 2; ++hf) rkw[h2][hf] = *(const f32x4*)(rw_rk + hh * 64 + 32 * h2 + 16 * hf + 4 * g);
                            for (int s = 0; s < NCH + 2; ++s) {
                                if (s >= 1 && s <= NCH) { LAS unsigned char* SB = lds + ((s - 1) % 3) * SLOTB;
                                    f32x4 abk = (f32x4){0.f, 0.f, 0.f, 0.f}, akk = abk, abr = abk, akr = abk;
                                    float bon = 0.f;
#pragma unroll
                                    for (int h2 = 0; h2 < 2; ++h2) { const int fo = r16 * 144 + (h2 * 4 + g) * 16;
                                        const bf16x8 fk = *(const LAS bf16x8*)(SB + O_KT + fo), fr_ = *(const LAS bf16x8*)(SB + O_RT + fo), fb = *(const LAS bf16x8*)(SB + O_BT + fo), fl = *(const LAS bf16x8*)(SB + O_KL + fo);
                                        abk = __builtin_amdgcn_mfma_f32_16x16x32_bf16(fk, fb, abk, 0, 0, 0); akk = __builtin_amdgcn_mfma_f32_16x16x32_bf16(fk, fl, akk, 0, 0, 0);
                                        abr = __builtin_amdgcn_mfma_f32_16x16x32_bf16(fr_, fb, abr, 0, 0, 0); akr = __builtin_amdgcn_mfma_f32_16x16x32_bf16(fr_, fl, akr, 0, 0, 0);
                                        { const u32x4 ur = __builtin_bit_cast(u32x4, fr_), ul = __builtin_bit_cast(u32x4, fl);
#pragma unroll
                                          for (int w_ = 0; w_ < 4; ++w_) { const f32x4 rk4_ = rkw[h2][w_ >> 1]; const int e0 = 2 * (w_ & 1);
                                              bon += __builtin_bit_cast(float, ur[w_] << 16) * __builtin_bit_cast(float, ul[w_] << 16) * rk4_[e0] + __builtin_bit_cast(float, ur[w_] & 0xffff0000u) * __builtin_bit_cast(float, ul[w_] & 0xffff0000u) * rk4_[e0 + 1]; } } }
#pragma unroll
                                    for (int i = 0; i < 4; ++i) { const int tt = 4 * g + i; const bool st = r16 < tt, in = r16 <= tt;
                                        const float vbk = st ? abk[i] : 0.f, vkk = st ? akk[i] : 0.f, vbr = in ? abr[i] : 0.f, vkr = in ? akr[i] : 0.f;
                                        *(LAS unsigned short*)(SB + O_ABK + tt * 32 + r16 * 2) = BF1(vbk); *(LAS unsigned short*)(SB + O_AKK + tt * 32 + r16 * 2) = BF1(vkk);
                                        *(LAS unsigned short*)(SB + O_ABR + tt * 32 + r16 * 2) = BF1(vbr); *(LAS unsigned short*)(SB + O_AKR + tt * 32 + r16 * 2) = BF1(vkr);
                                        if ((r16 >> 2) == g) *(LAS float*)(SB + O_DG + (g * 16 + i * 4 + (r16 & 3)) * 4) = vbk; }
                                    bon += xor16f(bon); bon = sum_xor32(bon, lane);
                                    if (cq == 0 && g == 0) BONUS[(rowbase + (size_t)(s - 1) * CH + r16) * 32 + hh] = bon;
                                    { const LAS float* sp_ = (const LAS float*)(lds + 3 * SLOTB + 4096) + ((s - 1) % 3) * 64 + r16;
                                      const float ssn = (sp_[0] + sp_[16]) + (sp_[32] + sp_[48]);
                                      if (g == 0) ((LAS float*)(lds + 3 * SLOTB + 4096 + 768))[((s - 1) % 3) * 16 + r16] = frcp(fmaxf(ssn, 1e-24f)); }
                                }
                                STEP_BARRIER();
                            }
                        } else if (wave == 0) {
                            const int r16 = lane & 15, g = lane >> 4;
                            f32x4 Sacc[4]; u32x4 Sb[2];
#pragma unroll
                            for (int i = 0; i < 4; ++i) Sacc[i] = (f32x4){0.f, 0.f, 0.f, 0.f};
                            Sb[0] = (u32x4){0u, 0u, 0u, 0u}; Sb[1] = Sb[0];
                            for (int s = 0; s < NCH + 2; ++s) {
                                if (s >= 2) { const int c = s - 2; LAS unsigned char* SB = lds + (c % 3) * SLOTB;
                                    const int fo = r16 * 144 + g * 16, ao = r16 * 32 + g * 8;
                                    const bf16x8 kt0 = *(const LAS bf16x8*)(SB + O_KT + fo), kt1 = *(const LAS bf16x8*)(SB + O_KT + fo + 64), rt0 = *(const LAS bf16x8*)(SB + O_RT + fo), rt1 = *(const LAS bf16x8*)(SB + O_RT + fo + 64);
                                    const s16x4 a_kk = *(const LAS s16x4*)(SB + O_AKK + ao), a_kr = *(const LAS s16x4*)(SB + O_AKR + ao), a_br = *(const LAS s16x4*)(SB + O_ABR + ao), a_bk = *(const LAS s16x4*)(SB + O_ABK + ao);
                                    const s16x4 vf = *(const LAS s16x4*)(SB + O_VT + ao);
                                    const f32x4 dg1 = *(const LAS f32x4*)(SB + O_DG + (g * 16 + 4) * 4), dg2 = *(const LAS f32x4*)(SB + O_DG + (g * 16 + 8) * 4), dg3 = *(const LAS f32x4*)(SB + O_DG + (g * 16 + 12) * 4);
                                    const bf16x8 sb0 = __builtin_bit_cast(bf16x8, Sb[0]), sb1 = __builtin_bit_cast(bf16x8, Sb[1]);
                                    f32x4 U = __builtin_amdgcn_mfma_f32_16x16x32_bf16(kt0, sb0, (f32x4){0.f, 0.f, 0.f, 0.f}, 0, 0, 0);
                                    U = __builtin_amdgcn_mfma_f32_16x16x32_bf16(kt1, sb1, U, 0, 0, 0);
                                    U = __builtin_amdgcn_mfma_f32_16x16x16bf16_1k(a_kk, vf, U, 0, 0, 0);
                                    f32x4 Y = __builtin_amdgcn_mfma_f32_16x16x32_bf16(rt0, sb0, (f32x4){0.f, 0.f, 0.f, 0.f}, 0, 0, 0);
                                    Y = __builtin_amdgcn_mfma_f32_16x16x32_bf16(rt1, sb1, Y, 0, 0, 0);
                                    Y = __builtin_amdgcn_mfma_f32_16x16x16bf16_1k(a_kr, vf, Y, 0, 0, 0);
                                    const f32x4 dv = *(const LAS f32x4*)(lds + 3 * SLOTB + 4096 + 768 + ((c % 3) * 16 + 4 * g) * 4);
                                    f32x4 Z = (f32x4){0.f, 0.f, 0.f, 0.f};
#pragma unroll
                                    for (int gb = 0; gb < 4; ++gb) {
                                        const float z0 = U[0] * dv[0], z1 = (U[1] - dg1[0] * z0) * dv[1], z2 = (U[2] - dg2[0] * z0 - dg2[1] * z1) * dv[2], z3 = (U[3] - dg3[0] * z0 - dg3[1] * z1 - dg3[2] * z2) * dv[3];
                                        const bool sel = (g == gb);
                                        Z[0] = sel ? z0 : Z[0]; Z[1] = sel ? z1 : Z[1]; Z[2] = sel ? z2 : Z[2]; Z[3] = sel ? z3 : Z[3];
                                        if (gb < 3) { u32x2 nz; nz.x = sel ? cvtpk(-z0, -z1) : 0u; nz.y = sel ? cvtpk(-z2, -z3) : 0u;
                                            U = __builtin_amdgcn_mfma_f32_16x16x16bf16_1k(a_bk, __builtin_bit_cast(s16x4, nz), U, 0, 0, 0); } }
                                    u32x2 nzp; nzp.x = cvtpk(-Z[0], -Z[1]); nzp.y = cvtpk(-Z[2], -Z[3]); const s16x4 nzf = __builtin_bit_cast(s16x4, nzp);
                                    Y = __builtin_amdgcn_mfma_f32_16x16x16bf16_1k(a_br, nzf, Y, 0, 0, 0);
                                    { float* yd = YRAW + (rowbase + (size_t)c * CH + 4 * g) * D + hh * 64 + 16 * cq + r16;
#pragma unroll
                                      for (int i = 0; i < 4; ++i) yd[(size_t)i * D] = Y[i]; }
#pragma unroll
                                    for (int tau = 0; tau < 4; ++tau) { const f32x4 gm = *(const LAS f32x4*)(SB + O_GAM + (16 * tau + 4 * g) * 4);
                                        const s16x4 kh = *(const LAS s16x4*)(SB + O_KH + (16 * tau + r16) * 32 + g * 8), bhf = *(const LAS s16x4*)(SB + O_BH + (16 * tau + r16) * 32 + g * 8);
                                        f32x4 a = Sacc[tau] * gm; a = __builtin_amdgcn_mfma_f32_16x16x16bf16_1k(kh, vf, a, 0, 0, 0); a = __builtin_amdgcn_mfma_f32_16x16x16bf16_1k(bhf, nzf, a, 0, 0, 0); Sacc[tau] = a; }
#pragma unroll
                                    for (int h2 = 0; h2 < 2; ++h2) { const f32x4 lo = Sacc[2 * h2], hi = Sacc[2 * h2 + 1];
                                        Sb[h2] = (u32x4){cvtpk(lo[0], lo[1]), cvtpk(lo[2], lo[3]), cvtpk(hi[0], hi[1]), cvtpk(hi[2], hi[3])}; }
                                }
                                STEP_BARRIER();
                            }
#pragma unroll
                            for (int tau = 0; tau < 4; ++tau) *(f32x4*)(out + O_PWKV + ((size_t)(bh * 64 + 16 * cq + r16)) * 64 + 16 * tau + 4 * g) = Sacc[tau];
                        } else if (G == 256) {
                            const int w2 = wave - 2;
                            f32x4 Zk[1][4], Za[1][4], Zw[1][4], Zr[1][4], ZS[1], Zkkw[1], Zkaw[1]; float Zv[1][4]; int Ztask[1];
#define S_ISSUE(x_, i_) do { const int stk_ = __builtin_amdgcn_readfirstlane(((i_) * 2 + w2) * 256 + vcu); Ztask[x_] = stk_; const int bs_ = stk_ >> 9, h_ = (stk_ >> 4) & 31, r0s_ = 4 * (stk_ & 15); \
                                ZS[x_] = *(const f32x4*)(st_wkv + (((size_t)bs_ * NH + h_) * 64 + r0s_) * 64 + (unsigned)(rg * 64 + 4 * kq)); Zkkw[x_] = *(const f32x4*)(rw_kk + h_ * 64 + (unsigned)(4 * kq)); Zkaw[x_] = *(const f32x4*)(rw_ka + h_ * 64 + (unsigned)(4 * kq)); \
                                _Pragma("unroll") for (int t = 0; t < DEC_T; ++t) { const size_t rw_ = (size_t)NPR + 4 * bs_ + t; \
                                    Zk[x_][t] = *(const f32x4*)(Kk + rw_ * LDR + h_ * 64 + (unsigned)(4 * kq)); Za[x_][t] = *(const f32x4*)(Aa + rw_ * D + h_ * 64 + (unsigned)(4 * kq)); Zw[x_][t] = *(const f32x4*)(Dec + rw_ * D + h_ * 64 + (unsigned)(4 * kq)); Zr[x_][t] = *(const f32x4*)(Rr + rw_ * LDR + h_ * 64 + (unsigned)(4 * kq)); \
                                    Zv[x_][t] = *(Vv + rw_ * LDR + h_ * 64 + r0s_ + (unsigned)rg); } } while (0)
#define S_FINISH(x_) do { const int stk_ = Ztask[x_]; const int bs_ = stk_ >> 9, h_ = (stk_ >> 4) & 31, row_ = 4 * (stk_ & 15) + rg; \
                                _Pragma("unroll") for (int t = 0; t < DEC_T; ++t) { f32x4 kk, kka, kp; rwkv_derive(Zk[x_][t], Za[x_][t], Zkkw[x_], Zkaw[x_], kk, kka, kp); float y; \
                                    scan_step(ZS[x_], Zw[x_][t], kk, kka, kp, Zr[x_][t], Zv[x_][t], y); \
                                    if (kq == 0) YRAW[((size_t)NPR + 4 * bs_ + t) * D + h_ * 64 + row_] = y; } \
                                *(f32x4*)(out + O_SWKV + (((size_t)bs_ * NH + h_) * 64 + row_) * 64 + 4 * kq) = ZS[x_]; } while (0)
                            for (int p = 0; p < NCH / 2; ++p) {
                                S_ISSUE(0, p); STEP_BARRIER();
                                S_FINISH(0); STEP_BARRIER();
                            }
                            STEP_BARRIER(); STEP_BARRIER();
#undef S_ISSUE
#undef S_FINISH
                        } else {
                            for (int s = 0; s < NCH + 2; ++s) STEP_BARRIER();
                        }
                    }
#undef BF1
#undef STEP_BARRIER
                    if (G != 256) for (int task = gw; task < DEC_B * NH * 16; task += NGW) SAMPLE_TASK(task);
#undef SAMPLE_TASK
#undef SAMPLE_ISSUE
#undef SAMPLE_FINISH
                }
                PH_END
                PH_BEGIN
                {
                    const float* Rr = RKV; const float* Kk = RKV + D; const float* Vv = RKV + 2 * D;
                    const float* Aa = DAG + (size_t)M * D; const bf16_t* Gg = (const bf16_t*)(DAG + 2 * (size_t)M * D);
                    QROWS_SETUP (void)qc;
                    for (int it = wave; it < qnit; it += NWAVES) { const int m = QROW(it); if (QSKIP(it, m)) continue; const size_t ro = (size_t)m * D, ro2 = (size_t)m * LDR;
#pragma unroll 2
                        for (int j = 0; j < 8; ++j) { const int e = 4 * lane + 256 * j;
                            const f32x4 y = *(const f32x4*)(YRAW + ro + e);
                            const float mean = row16_sum((y.x + y.y) + (y.z + y.w)) * (1.0f / 64.0f);
                            const f32x4 dv = y - mean; const float var = row16_sum((dv.x * dv.x + dv.y * dv.y) + (dv.z * dv.z + dv.w * dv.w)) * (1.0f / 64.0f);
                            const float rstd = 1.0f / sqrtf(var + GN_EPS);
                            const f32x4 gw4 = *(const f32x4*)(rw_gn_w + e), gb4 = *(const f32x4*)(rw_gn_b + e);
                            const f32x4 v4 = *(const f32x4*)(Vv + ro2 + e), g4 = bf4(*(const u32x2*)(Gg + ro + e));
                            float bs;
                            if (m < NPR) bs = BONUS[(size_t)m * 32 + (e >> 6)];
                            else { const f32x4 r4 = *(const f32x4*)(Rr + ro2 + e), k4 = *(const f32x4*)(Kk + ro2 + e), a4 = *(const f32x4*)(Aa + ro + e);
                                const f32x4 kaw = *(const f32x4*)(rw_ka + e), rk4 = *(const f32x4*)(rw_rk + e);
                                const f32x4 kp = k4 * (1.0f + (a4 - 1.0f) * kaw); const f32x4 pr = r4 * kp * rk4;
                                bs = row16_sum((pr.x + pr.y) + (pr.z + pr.w)); }
                            const f32x4 o = ((dv * rstd) * gw4 + gb4 + bs * v4) * g4;
                            u32x2 w; w.x = cvtpk(o.x, o.y); w.y = cvtpk(o.z, o.w); *(u32x2*)(HA + ro + e) = w; } }
                }
                PH_END
                ++qslot;
            } else {
                PH_BEGIN
                {
                    QROWS_SETUP
                    for (;;) { int it; QPOP(it); if (it >= qnit) break; const int m = QROW(it); if (QSKIP(it, m)) continue; const int b = bidx_of_row(m);
                        const float* mb = (MOD + (size_t)layer * NCB * NMOD * D) + (size_t)b * NMOD * D + 3 * D;
                        Pend pd{nullptr, 0, nullptr, nullptr, 0.f}; MAKE_PEND(pd, m, b, 11, layer, 2, nullptr, 0.5f);
                        f32x4 h[8]; norm_mod_row(XBUF(xcur) + (size_t)m * D, true, (norm_g + (size_t)(layer * 3 + sub) * D), mb, mb + D, lane, h, XBUF(xcur ^ 1) + (size_t)m * D, pd);
                        store_bf16_row(HA + (size_t)m * D, h, lane); }
                }
                PH_END
                ++qslot;
                xcur ^= 1;
                PH_BEGIN
                {
                    pg8::Sched<pg8::ASel0, pg8::SplitOrder<34, 10, 32, PMS_QKV, 2>> S; S.ord.init(G, bx); S.A = (const char*)HA; S.Bt = (const char*)W_QKV; S.tstep = (size_t)256 * D * 2; S.astride = 0;
                    pg8::EpiF32 E{QKV, QKVW, sw_bqkv, SLAB, ROW0_QKV, NROWS_QKV};
                    pg8::gemm_phase(lds, tid, D, S, E);
                }
                PH_END
                PH_BEGIN
                {
                    const int i0 = 4 * (lane & 7), hsel = lane >> 3; const f32x4 invf = *(const f32x4*)(INV_FREQ + i0);
                    QROWS_SETUP (void)qc;
                    for (int it = wave; it < qnit; it += NWAVES) { const int m = QROW(it); if (QSKIP(it, m)) continue;
                        const int pos = m < NPR ? (m & 4095) : 8192 + ((m - NPR) & 3);
                        f32x4 cs, sn;
#pragma unroll
                        for (int e = 0; e < 4; ++e) { const float ang = (float)pos * invf[e]; const double a = (double)ang * 0.15915494309189535; const float fr = (float)(a - __builtin_rint(a));
                            cs[e] = __builtin_amdgcn_cosf(fr); sn[e] = __builtin_amdgcn_sinf(fr); }
                        const float* qrow = QKV + (size_t)m * QKVW;
                        const bool spl = m >= ROW0_QKV; const float* sl0 = SLAB + (size_t)(spl ? m - ROW0_QKV : 0) * QKVW; const float* sl1 = sl0 + (size_t)NROWS_QKV * QKVW; const float* bq = sw_bqkv;
#define QV4(c_) (spl ? (*(const f32x4*)(sl0 + (c_)) + *(const f32x4*)(sl1 + (c_))) + *(const f32x4*)(bq + (c_)) : *(const f32x4*)(qrow + (c_)))
#pragma unroll
                        for (int p = 0; p < 4; ++p) { const int hd0 = (8 * p + hsel) * 64 + i0; const f32x4 x1 = QV4(hd0), x2 = QV4(hd0 + 32);
                            const f32x4 o1 = (x1 * cs - x2 * sn) * QSCALE, o2 = (x2 * cs + x1 * sn) * QSCALE;
                            u32x2 w1, w2; w1.x = cvtpk(o1.x, o1.y); w1.y = cvtpk(o1.z, o1.w); w2.x = cvtpk(o2.x, o2.y); w2.y = cvtpk(o2.z, o2.w);
                            *(u32x2*)(QB + (size_t)m * D + hd0) = w1; *(u32x2*)(QB + (size_t)m * D + hd0 + 32) = w2; }
                        float* kout = nullptr; float* vout = nullptr;
                        if (m < NPR) { const int t = m & 4095; if (t >= SEQ - WIN) { const size_t o = ((size_t)(m >> 12) * WIN + (t - (SEQ - WIN))) * 256; kout = out + O_PK + o; vout = out + O_PV + o; } }
                        else { const int bs = (m - NPR) >> 2, t = (m - NPR) & 3; const size_t o = ((size_t)bs * WIN + (WIN - DEC_T) + t) * 256; kout = out + O_SK + o; vout = out + O_SV + o; }
                        if (hsel < 4) { const int hd0 = hsel * 64 + i0; const f32x4 x1 = QV4(D + hd0), x2 = QV4(D + hd0 + 32);
                            const f32x4 o1 = x1 * cs - x2 * sn, o2 = x2 * cs + x1 * sn;
                            u32x2 w1, w2; w1.x = cvtpk(o1.x, o1.y); w1.y = cvtpk(o1.z, o1.w); w2.x = cvtpk(o2.x, o2.y); w2.y = cvtpk(o2.z, o2.w);
                            *(u32x2*)(KB + (size_t)m * 256 + hd0) = w1; *(u32x2*)(KB + (size_t)m * 256 + hd0 + 32) = w2;
                            if (kout) { *(f32x4*)(kout + hd0) = o1; *(f32x4*)(kout + hd0 + 32) = o2; } }
                        { const int vc = D + 256 + 4 * lane; const f32x4 v4 = QV4(vc); u32x2 w; w.x = cvtpk(v4.x, v4.y); w.y = cvtpk(v4.z, v4.w); *(u32x2*)(VB + (size_t)m * 256 + 4 * lane) = w;
                          if (vout) *(f32x4*)(vout + 4 * lane) = v4; }
                    }
#undef QV4
                    for (int idx = gw * 64 + lane; idx < DEC_B * (WIN - DEC_T) * 64; idx += NGW * 64) { const int bs = idx / ((WIN - DEC_T) * 64), rem = idx % ((WIN - DEC_T) * 64);
                        const size_t src = (size_t)bs * WIN * 256 + (size_t)DEC_T * 256 + (size_t)rem * 4, dst = (size_t)bs * WIN * 256 + (size_t)rem * 4;
                        *(f32x4*)(out + O_SK + dst) = *(const f32x4*)(cache_k + src); *(f32x4*)(out + O_SV + dst) = *(const f32x4*)(cache_v + src); }
                }
                PH_END
                ++qslot;
                PH_BEGIN
                {
                    constexpr int KST = 144, VST = 520;
                    LAS unsigned char* Ks = lds; LAS unsigned char* Vt = lds + 256 * KST;
                    const int r = lane & 31, hf = lane >> 5;
                    for (int u = vcu; u < 256; u += G) {
                        const int b = u >> 7, kvh = (u >> 5) & 3, blk = u & 31;
                        __syncthreads();
                        for (int idx = tid; idx < 2048; idx += NTHREADS) { const int key = idx >> 3, ch = idx & 7; const int kpos = 128 * (blk - 1) + key;
                            u32x4 kv = (u32x4){0u, 0u, 0u, 0u}, vv = (u32x4){0u, 0u, 0u, 0u};
                            if (kpos >= 0) { const size_t o = ((size_t)b * SEQ + kpos) * 256 + kvh * 64 + 8 * ch; kv = *(const u32x4*)(KB + o); vv = *(const u32x4*)(VB + o); }
                            *(LAS u32x4*)(Ks + key * KST + ch * 16) = kv;
                            LAS bf16_t* vt = (LAS bf16_t*)(Vt + (8 * ch) * VST) + key;
                            vt[0 * (VST / 2)] = (bf16_t)(vv.x & 0xffffu); vt[1 * (VST / 2)] = (bf16_t)(vv.x >> 16); vt[2 * (VST / 2)] = (bf16_t)(vv.y & 0xffffu); vt[3 * (VST / 2)] = (bf16_t)(vv.y >> 16);
                            vt[4 * (VST / 2)] = (bf16_t)(vv.z & 0xffffu); vt[5 * (VST / 2)] = (bf16_t)(vv.z >> 16); vt[6 * (VST / 2)] = (bf16_t)(vv.w & 0xffffu); vt[7 * (VST / 2)] = (bf16_t)(vv.w >> 16); }
                        __syncthreads();
                        const int hq = kvh * 8 + wave; const float sink2 = sw_sink[hq] * LOG2E;
                        for (int sb = 0; sb < 4; ++sb) {
                            const size_t qrow = (size_t)b * SEQ + 128 * blk + 32 * sb + r;
                            bf16x8 qf[4];
#pragma unroll
                            for (int kk = 0; kk < 4; ++kk) qf[kk] = *(const bf16x8*)(QB + qrow * D + hq * 64 + 16 * kk + 8 * hf);
                            f32x16 s[5];
#pragma unroll
                            for (int i = 0; i < 5; ++i) { const int jt = sb + i;
#pragma unroll
                                for (int e = 0; e < 16; ++e) s[i][e] = 0.f;
#pragma unroll
                                for (int kk = 0; kk < 4; ++kk) { const bf16x8 a = *(const LAS bf16x8*)(Ks + (32 * jt + r) * KST + (16 * kk + 8 * hf) * 2);
                                    s[i] = __builtin_amdgcn_mfma_f32_32x32x16_bf16(a, qf[kk], s[i], 0, 0, 0); } }
                            float mx = -3.0e38f;
#pragma unroll
                            for (int i = 0; i < 5; ++i) { const bool tile_ok = (blk > 0) || (sb + i >= 4);
#pragma unroll
                                for (int e = 0; e < 16; ++e) { const int cr = (e & 3) + 8 * (e >> 2) + 4 * hf;
                                    bool ok = tile_ok; if (i == 0) ok = ok && (cr > r); if (i == 4) ok = ok && (cr <= r);
                                    s[i][e] = ok ? s[i][e] : -3.0e38f; mx = fmaxf(mx, s[i][e]); } }
                            mx = max_xor32(mx, lane); const float m2 = fmaxf(mx, sink2);
                            float sum = 0.f;
#pragma unroll
                            for (int i = 0; i < 5; ++i)
#pragma unroll
                                for (int e = 0; e < 16; ++e) { s[i][e] = fexp2(s[i][e] - m2); sum += s[i][e]; }
                            sum = sum_xor32(sum, lane);
                            const float inv = 1.0f / (sum + fexp2(sink2 - m2));
                            f32x16 o[2];
#pragma unroll
                            for (int e = 0; e < 16; ++e) { o[0][e] = 0.f; o[1][e] = 0.f; }
#pragma unroll
                            for (int i = 0; i < 5; ++i) { const int jt = sb + i;
#pragma unroll
                                for (int s2 = 0; s2 < 2; ++s2) {
                                    u32x4 pw; pw.x = cvtpk(s[i][8 * s2 + 0] * inv, s[i][8 * s2 + 1] * inv); pw.y = cvtpk(s[i][8 * s2 + 2] * inv, s[i][8 * s2 + 3] * inv);
                                    pw.z = cvtpk(s[i][8 * s2 + 4] * inv, s[i][8 * s2 + 5] * inv); pw.w = cvtpk(s[i][8 * s2 + 6] * inv, s[i][8 * s2 + 7] * inv);
                                    const bf16x8 pa = __builtin_bit_cast(bf16x8, pw);
#pragma unroll
                                    for (int dd = 0; dd < 2; ++dd) { const LAS unsigned char* vp = Vt + (32 * dd + r) * VST + (32 * jt + 16 * s2 + 4 * hf) * 2;
                                        const u32x2 lo = *(const LAS u32x2*)(vp), hi2 = *(const LAS u32x2*)(vp + 16);
                                        const u32x4 vb = (u32x4){lo.x, lo.y, hi2.x, hi2.y};
                                        o[dd] = __builtin_amdgcn_mfma_f32_32x32x16_bf16(pa, __builtin_bit_cast(bf16x8, vb), o[dd], 0, 0, 0); } } }
                            bf16_t* ob = HA + ((size_t)b * SEQ + 128 * blk + 32 * sb) * D + hq * 64 + r;
#pragma unroll
                            for (int e = 0; e < 16; ++e) { const int cr = (e & 3) + 8 * (e >> 2) + 4 * hf;
                                ob[(size_t)cr * D] = (bf16_t)(cvtpk(o[0][e], 0.f) & 0xffffu); ob[(size_t)cr * D + 32] = (bf16_t)(cvtpk(o[1][e], 0.f) & 0xffffu); }
                        }
                    }
                    {
                        const int rg = lane >> 4, kq = lane & 15;
                        for (int task = gw; task < DEC_B * NH; task += NGW) {
                            const int bs = task >> 5, hq = task & 31, kvh = hq >> 3; const int m0 = NPR + 4 * bs;
                            f32x4 q4[4], acc[4]; float mrun[4], sum[4];
                            const float sink2 = sw_sink[hq] * LOG2E;
#pragma unroll
                            for (int t = 0; t < 4; ++t) { const u32x2 qw = *(const u32x2*)(QB + (size_t)(m0 + t) * D + hq * 64 + 4 * kq);
                                q4[t] = (f32x4){bf2f((unsigned short)(qw.x & 0xffffu)), bf2f((unsigned short)(qw.x >> 16)), bf2f((unsigned short)(qw.y & 0xffffu)), bf2f((unsigned short)(qw.y >> 16))};
                                mrun[t] = sink2; sum[t] = 0.f; acc[t] = (f32x4){0.f, 0.f, 0.f, 0.f}; }
                            const float* ckb = cache_k + (size_t)bs * WIN * 256 + kvh * 64 + 4 * kq; const float* cvb = cache_v + (size_t)bs * WIN * 256 + kvh * 64 + 4 * kq;
                            const float* nkb = out + O_SK + ((size_t)bs * WIN + (WIN - DEC_T)) * 256 + kvh * 64 + 4 * kq; const float* nvb = out + O_SV + ((size_t)bs * WIN + (WIN - DEC_T)) * 256 + kvh * 64 + 4 * kq;
#pragma unroll 3
                            for (int it = 0; it < 33; ++it) { const int j = 4 * it + rg;
                                const f32x4 k4 = *(const f32x4*)(j < WIN ? ckb + (size_t)j * 256 : nkb + (size_t)(j - WIN) * 256);
                                const f32x4 v4 = *(const f32x4*)(j < WIN ? cvb + (size_t)j * 256 : nvb + (size_t)(j - WIN) * 256);
#pragma unroll
                                for (int t = 0; t < 4; ++t) {
                                    float d = (q4[t].x * k4.x + q4[t].y * k4.y) + (q4[t].z * k4.z + q4[t].w * k4.w); d = row16_sum(d);
                                    const bool ok = j < WIN ? (j >= t + 1) : (j - WIN <= t);
                                    if (ok) { const float mn = fmaxf(mrun[t], d); const float scl = fexp2(mrun[t] - mn), p = fexp2(d - mn); sum[t] = sum[t] * scl + p; acc[t] = acc[t] * scl + p * v4; mrun[t] = mn; } } }
#pragma unroll
                            for (int t = 0; t < 4; ++t) {
                                float mall = fmaxf(mrun[t], xor16f(mrun[t])); mall = max_xor32(mall, lane);
                                const float f = fexp2(mrun[t] - mall); float sm = sum[t] * f; f32x4 a = acc[t] * f;
                                sm += xor16f(sm); sm = sum_xor32(sm, lane);
#pragma unroll
                                for (int e = 0; e < 4; ++e) { float t_ = a[e]; t_ += xor16f(t_); a[e] = sum_xor32(t_, lane); }
                                const float inv = 1.0f / (sm + fexp2(sink2 - mall));
                                if (rg == 0) { u32x2 w; w.x = cvtpk(a.x * inv, a.y * inv); w.y = cvtpk(a.z * inv, a.w * inv); *(u32x2*)(HA + (size_t)(m0 + t) * D + hq * 64 + 4 * kq) = w; } }
                        }
                    }
                }
                PH_END
            }
            if (sub == 1) {
                PH_BEGIN
                {
                    pg8::Sched<pg8::ASel0, pg8::SplitOrder<34, 8, 32, 32, 8>> S; S.ord.init(G, bx); S.A = (const char*)HA; S.Bt = (const char*)(layer == 0 ? W_RWO : W_SWO); S.tstep = (size_t)256 * D * 2; S.astride = 0;
                    pg8::EpiDelta E{(bf16_t*)DELTA, SLAB};
                    pg8::gemm_phase(lds, tid, D, S, E);
                }
                PH_END
            }
        }
    }
    PH_BEGIN
    {
        QROWS_SETUP
        for (;;) { int it; QPOP(it); if (it >= qnit) break; const int m = QROW(it); if (QSKIP(it, m)) continue;
            f32x4 v[8]; float ss = 0.f; Pend pd{nullptr, 0, nullptr, nullptr, 0.f}; MAKE_PEND(pd, m, bidx_of_row(m), 11, 1, 8, nullptr, 0.5f);
            load_x_row(XBUF(xcur) + (size_t)m * D, true, lane, v, pd);
#pragma unroll
            for (int j = 0; j < 8; ++j) ss += (v[j].x * v[j].x + v[j].y * v[j].y) + (v[j].z * v[j].z + v[j].w * v[j].w);
            ss = wave_sum(ss); const float rs = 1.0f / sqrtf(ss * (1.0f / D) + RMS_EPS);
#pragma unroll
            for (int j = 0; j < 8; ++j) ((f32x4*)(out + O_Y + (size_t)m * D))[lane + 64 * j] = v[j] * rs * ((const f32x4*)final_g)[lane + 64 * j];
        }
    }
#if PROBE_MASK
    PH_END
    PH_BEGIN
    {
        const size_t offs[11] = {0, (size_t)NPR * D, O_PWKV, O_PSHIFT, O_PK, O_PV, O_SWKV, O_SSHIFT, O_SK, O_SV, O_END};
#pragma unroll
        for (int j = 0; j < 10; ++j) if ((PROBE_MASK >> j) & 1) {
            for (size_t i = offs[j] + (size_t)gw * 64 + lane; i < offs[j + 1]; i += (size_t)NGW * 64) out[i] *= 0.9f; }
    }
#endif
    PH_END_LAST
#undef PH_BEGIN
#undef PH_END
#undef PH_END_LAST
#undef PH_SETUP
#undef PH_BARRIER
}

#undef x_prompt
#undef x_sample
#undef st_wkv
#undef st_shift
#undef cache_k
#undef cache_v
#undef c_prompt
#undef c_sample
#undef norm_g
#undef w_ada
#undef b_ada
#undef w_ffn_in
#undef w_ffn_out
#undef rw_mu
#undef rw_wrkv
#undef rw_w0
#undef rw_w1
#undef rw_w2
#undef rw_a0
#undef rw_a1
#undef rw_a2
#undef rw_g1
#undef rw_g2
#undef rw_kk
#undef rw_ka
#undef rw_rk
#undef rw_gn_w
#undef rw_gn_b
#undef rw_wo
#undef sw_wqkv
#undef sw_bqkv
#undef sw_sink
#undef sw_wo
#undef sw_bo
#undef final_g
#undef W_ADA
#undef W_FIN
#undef W_FOUT
#undef W_RKVL1
#undef W_L2
#undef W_RWO
#undef W_QKV
#undef W_SWO
#undef CS
#undef MOD
#undef X
#undef HA
#undef ACT
#undef XA6
#undef DAG
#undef RKV
#undef L1OUT
#undef YRAW
#undef QKV
#undef QB
#undef KB
#undef VB
#undef SLAB
#undef DELTA
#undef XBUF
#undef out
extern "C" void kernel_launch(void* const* d_in, const int* in_sizes, int n_in, void* d_out, int out_size, void* d_ws, size_t ws_size, hipStream_t stream) {
    static int grid = 0;
    if (grid == 0) {
        if (n_in != 35 || (size_t)out_size != O_END || ws_size < WS_END) { fprintf(stderr, "kernel_launch: unexpected sizes: n_in %d out %d ws %zu (need %zu)\n", n_in, out_size, ws_size, (size_t)WS_END); grid = -1; return; }
        int dev = 0, cus = 0, per_cu = 0;
        if (hipGetDevice(&dev) != hipSuccess || hipDeviceGetAttribute(&cus, hipDeviceAttributeMultiprocessorCount, dev) != hipSuccess) { grid = -1; return; }
        if (hipFuncSetAttribute((const void*)mk_fwd, hipFuncAttributeMaxDynamicSharedMemorySize, LDS_BYTES) != hipSuccess) { fprintf(stderr, "kernel_launch: hipFuncSetAttribute failed\n"); grid = -1; return; }
        if (hipOccupancyMaxActiveBlocksPerMultiprocessor(&per_cu, (const void*)mk_fwd, NTHREADS, LDS_BYTES) != hipSuccess || per_cu < 1) fprintf(stderr, "kernel_launch: occupancy query says %d\n", per_cu);
        (void)hipGetLastError();
        grid = cus;
    }
    if (grid < 0) return;
    (void)hipMemsetAsync((char*)d_ws + WS_CTL, 0, CTL_ZERO_BYTES, stream);
    Args a{};
    for (int i = 0; i < 35; ++i) a.in[i] = (const float*)d_in[i];
    a.out = (float*)d_out; a.ws = (unsigned char*)d_ws;
#if MK_PER_PHASE
    for (int p = 0; p < 28; ++p) { a.ph_lo = p; a.ph_hi = p + 1; hipLaunchKernelGGL(mk_fwd, dim3(grid), dim3(NTHREADS), LDS_BYTES, stream, a); }
#else
    a.ph_lo = 0; a.ph_hi = 1 << 20;
    hipLaunchKernelGGL(mk_fwd, dim3(grid), dim3(NTHREADS), LDS_BYTES, stream, a);
#endif
    const hipError_t le = hipPeekAtLastError();
    if (le != hipSuccess) fprintf(stderr, "kernel_launch: launch failed: %s\n", hipGetErrorName(le));
}
```

```cpp
#include <hip/hip_runtime.h>
#include <cstdio>
#include <cstdint>

#define LAS __attribute__((address_space(3)))
#define GAS __attribute__((address_space(1)))
typedef unsigned short bf16_t;
typedef short bf16x8 __attribute__((ext_vector_type(8)));
typedef short s16x4 __attribute__((ext_vector_type(4)));
typedef float f32x4 __attribute__((ext_vector_type(4)));
typedef float f32x2 __attribute__((ext_vector_type(2)));
typedef float f32x16 __attribute__((ext_vector_type(16)));
typedef unsigned u32x4 __attribute__((ext_vector_type(4)));
typedef unsigned u32x2 __attribute__((ext_vector_type(2)));
typedef __bf16 bf16x2_t __attribute__((ext_vector_type(2)));

#ifndef PROBE_MASK
#define PROBE_MASK 0
#endif
#ifndef MK_PER_PHASE
#define MK_PER_PHASE 0
#endif

constexpr int D = 2048, NPR = 8192, NSR = 512, M = NPR + NSR, SEQ = 4096, NCB = 130, FF = 5632, NH = 32, HD = 64, KVH = 4;
constexpr int QKVW = 2560, NMOD = 9, DEC_B = 128, DEC_T = 4, WIN = 128;
constexpr float RMS_EPS = 1e-6f, GN_EPS = 64e-5f, LOG2E = 1.4426950408889634f;
constexpr float QSCALE = 0.125f * LOG2E;
constexpr int NWAVES = 8, NTHREADS = 512;

constexpr size_t O_Y = 0, O_PWKV = 17825792, O_PSHIFT = 18087936, O_PK = 18092032, O_PV = 18157568, O_SWKV = 18223104, O_SSHIFT = 35000320, O_SK = 35262464, O_SV = 39456768, O_END = 43651072;

constexpr size_t MiB = 1u << 20;
constexpr size_t WS_CTL = 0, CTL_ZERO_BYTES = 1 * MiB;
constexpr size_t WS_WADA = 1 * MiB;
constexpr size_t WS_WFIN = 145 * MiB;
constexpr size_t WS_WFOUT = 321 * MiB;
constexpr size_t WS_WRKVL1 = 409 * MiB;
constexpr size_t WS_WL2 = 436 * MiB;
constexpr size_t WS_WRWO = 439 * MiB;
constexpr size_t WS_WQKV = 447 * MiB;
constexpr size_t WS_WSWO = 457 * MiB;
constexpr size_t WS_CS = 465 * MiB;
constexpr size_t WS_MOD = 466 * MiB;
constexpr size_t WS_X = 485 * MiB;
constexpr size_t WS_HA = 553 * MiB;
constexpr size_t WS_ARENA = 587 * MiB;
constexpr size_t WS_ACT = WS_ARENA;
constexpr size_t WS_XA6 = WS_ARENA;
constexpr size_t WS_DAG = WS_ARENA;
constexpr size_t WS_RKV = WS_ARENA + 204 * MiB;
constexpr size_t WS_L1OUT = WS_ARENA + 436 * MiB;
constexpr size_t WS_YRAW = WS_ARENA + 449 * MiB;
constexpr size_t WS_QKV = WS_ARENA;
constexpr size_t WS_QB = WS_ARENA + 85 * MiB;
constexpr size_t WS_KB = WS_ARENA + 119 * MiB;
constexpr size_t WS_VB = WS_ARENA + 124 * MiB;
constexpr size_t WS_SLAB = WS_ARENA + 517 * MiB;
constexpr size_t WS_DELTA = WS_ARENA + 565 * MiB;
constexpr size_t WS_X2 = WS_ARENA + 633 * MiB;
constexpr size_t WS_END = WS_ARENA + 701 * MiB;
constexpr int PMS_QKV = 25, ROW0_QKV = PMS_QKV * 256, NROWS_QKV = M - ROW0_QKV;
constexpr int LDR = 6912;
constexpr int CW_BAR = 4096;

constexpr int RING_BYTES = 131072, LDSCTL_OFF = RING_BYTES, MISC_OFF = LDSCTL_OFF + 320, LDS_BYTES = 147456;
constexpr int QCTR_OFF = LDSCTL_OFF + 1024;

#define RLX_AGENT __ATOMIC_RELAXED, __HIP_MEMORY_SCOPE_AGENT
#define LDS_WAIT() asm volatile("s_waitcnt lgkmcnt(0)" ::: "memory")
__device__ __forceinline__ unsigned cvtpk(float lo, float hi) { f32x2 v = {lo, hi}; bf16x2_t b = __builtin_convertvector(v, bf16x2_t); return __builtin_bit_cast(unsigned, b); }
__device__ __forceinline__ float bf2f(unsigned short u) { return __builtin_bit_cast(float, (unsigned)u << 16); }
__device__ __forceinline__ f32x4 bf4(u32x2 w) { return (f32x4){__builtin_bit_cast(float, w.x << 16), __builtin_bit_cast(float, w.x & 0xffff0000u), __builtin_bit_cast(float, w.y << 16), __builtin_bit_cast(float, w.y & 0xffff0000u)}; }
template <int CTRL> __device__ __forceinline__ float dppf(float x) { return __builtin_bit_cast(float, __builtin_amdgcn_update_dpp(0, __builtin_bit_cast(int, x), CTRL, 0xf, 0xf, false)); }
template <int CTRL> __device__ __forceinline__ float dppm(float x) { return __builtin_bit_cast(float, __builtin_amdgcn_update_dpp(0x3f800000, __builtin_bit_cast(int, x), CTRL, 0xf, 0xf, false)); }
__device__ __forceinline__ float row16_sum(float x) {
    x += dppf<0x128>(x); x += dppf<0x124>(x); x += dppf<0x122>(x); x += dppf<0x121>(x); return x;
}
__device__ __forceinline__ float xor16f(float x) { return __builtin_bit_cast(float, __builtin_amdgcn_ds_swizzle(__builtin_bit_cast(int, x), 0x401F)); }
__device__ __forceinline__ float other32(float x, int lane) { return __builtin_bit_cast(float, __builtin_amdgcn_ds_bpermute((lane ^ 32) << 2, __builtin_bit_cast(int, x))); }
__device__ __forceinline__ float sum_xor32(float x, int lane) { return x + other32(x, lane); }
__device__ __forceinline__ float max_xor32(float x, int lane) { return fmaxf(x, other32(x, lane)); }
__device__ __forceinline__ float wave_sum(float v) { v = row16_sum(v);
    const float a = __builtin_bit_cast(float, __builtin_amdgcn_readlane(__builtin_bit_cast(int, v), 0)), b = __builtin_bit_cast(float, __builtin_amdgcn_readlane(__builtin_bit_cast(int, v), 16));
    const float c = __builtin_bit_cast(float, __builtin_amdgcn_readlane(__builtin_bit_cast(int, v), 32)), d = __builtin_bit_cast(float, __builtin_amdgcn_readlane(__builtin_bit_cast(int, v), 48));
    return (a + b) + (c + d); }
__device__ __forceinline__ float fexp2(float x) { return __builtin_amdgcn_exp2f(x); }
__device__ __forceinline__ float frcp(float x) { return __builtin_amdgcn_rcpf(x); }
__device__ __forceinline__ float sigmoidf_(float x) { return frcp(1.f + fexp2(-x * LOG2E)); }
__device__ __forceinline__ float siluf_(float x) { return x * sigmoidf_(x); }
__device__ __forceinline__ float tanhf_(float x) { return 1.f - 2.f * frcp(1.f + fexp2(2.f * LOG2E * x)); }
__device__ __forceinline__ int bidx_of_row(int m) { return m < NPR ? (m >> 12) : 2 + ((m - NPR) >> 2); }

namespace pg8 {
constexpr int BM = 256, BK = 64, HALF = 128, HTB = HALF * BK * 2, STAGE_BYTES = 8 * HTB, NXCD = 8, WGM = 8;
__host__ __device__ __forceinline__ int lds_byte(int r, int c) { const int st = (r >> 4) * 2 + (c >> 5), rr = r & 15, cc = c & 31, ob = rr * 64 + cc * 2; return st * 1024 + (ob ^ (((ob >> 9) & 1) << 5)); }
__host__ __device__ __forceinline__ void stage_rc(int b, int& R, int& C) { const int st = b / 1024, sb = b % 1024, swz = sb ^ (((sb >> 9) & 1) << 5); R = (st >> 1) * 16 + swz / 64; C = (st & 1) * 32 + (swz % 64) / 2; }
__host__ __device__ __forceinline__ int perm32(int rho) { const int n = rho >> 4, i = rho & 15; return 8 * (i >> 2) + 4 * n + (i & 3); }

struct Unit { int pm, pn, s; };

template <int NM, int NN> struct StaticOrderT {
    static __device__ __forceinline__ void map(int L, int& pm, int& pn) {
        constexpr int nwg = NM * NN, q = nwg / NXCD, r = nwg % NXCD, nig = WGM * NN, tail = (NM % WGM) ? (NM % WGM) : WGM, lastfm = NM - tail;
        const int xcd = L % NXCD, off = L / NXCD; const int wgid = (xcd < r ? xcd * (q + 1) : r * (q + 1) + (xcd - r) * q) + off;
        const int gid = wgid / nig, fm = gid * WGM, rem = wgid - gid * nig;
        const int pmA = rem % WGM, pnA = rem / WGM, pmB = rem % tail, pnB = rem / tail;
        const bool last = fm >= lastfm;
        pm = fm + (last ? pmB : pmA); pn = last ? pnB : pnA;
    }
};
template <int NM, int NN, int NKF, int PMS, int S> struct SplitOrder {
    int G, c;
    __device__ __forceinline__ void init(int G_, int c_) { G = G_; c = c_; }
    __device__ __forceinline__ bool next(int i, int& pm, int& pn, int& s) const {
        constexpr int nfull = PMS * NN, total = nfull + (NM - PMS) * NN * S;
        const int L = i * G + c; if (L >= total) return false;
        int pm1, pn1; StaticOrderT<PMS, NN>::map(L < nfull ? L : 0, pm1, pn1);
        const int j = L - nfull, r = j / S, s2 = j - r * S, pm2 = PMS + r / NN, pn2 = r % NN;
        const bool full = L < nfull;
        pm = full ? pm1 : pm2; pn = full ? pn1 : pn2; s = full ? -1 : s2;
        return true;
    }
    static __device__ __forceinline__ int k0(const Unit& u) { return u.s < 0 ? 0 : u.s * (NKF / S); }
    static __device__ __forceinline__ int nk(const Unit& u) { return u.s < 0 ? NKF : NKF / S; }
};
struct ASel0   { __device__ __forceinline__ int operator()(int) const { return 0; } };
struct ASelRKV { __device__ __forceinline__ int operator()(int pn) const { const int a = pn >> 3, b = pn - 24; return (a < 3 ? a : 3) + (b > 0 ? b : 0); } };
struct ASelL2  { __device__ __forceinline__ int operator()(int pn) const { return pn >> 3; } };
template <class ASel, class Ord> struct Sched {
    Ord ord; const char* A; const char* Bt; size_t tstep, astride; ASel asel;
    __device__ __forceinline__ bool next(int i, int& pm, int& pn, int& s) const { return ord.next(i, pm, pn, s); }
    __device__ __forceinline__ const char* pa(const Unit& u) const { return A + (size_t)asel(u.pn) * astride + (size_t)u.pm * tstep + (size_t)Ord::k0(u) * (BK * 2); }
    __device__ __forceinline__ const char* pb(const Unit& u) const { return Bt + (size_t)u.pn * tstep + (size_t)Ord::k0(u) * (BK * 2); }
    __device__ __forceinline__ int nk(const Unit& u) const { return Ord::nk(u); }
};

template <class Epi, class SchedT>
__device__ __forceinline__ void gemm_phase(LAS unsigned char* lds, const int tid, const int K, const SchedT& S, const Epi& E) {
    const int wid = __builtin_amdgcn_readfirstlane(tid >> 6), lane = tid & 63, wr = wid >> 2, wc = wid & 3, fr = lane & 15, fq = lane >> 4;
    unsigned voffA[2], voffB[2];
#pragma unroll
    for (int i = 0; i < 2; ++i) { int R, C; stage_rc(tid * 16 + i * 8192, R, C); const int Rb = Epi::PERM ? ((R & ~31) + perm32(R & 31)) : R;
        voffA[i] = (unsigned)(R * K + C) * 2u; voffB[i] = (unsigned)(Rb * K + C) * 2u; }
    const size_t kstep = (size_t)(BK * 2);
    const size_t hstep = (size_t)HALF * K * 2;
    const unsigned ldsw = (unsigned)wid * 1024u;
    const int aoff = lds_byte(wr * 64 + fr, fq * 8), boff = lds_byte(wc * 32 + fr, fq * 8);
#define PG8_SA(b, h) (((b) * 2 + (h)) * HTB)
#define PG8_SB(b, h) ((4 + (b) * 2 + (h)) * HTB)
#define PG8_STAGE(bufoff, gbase, voff) do { _Pragma("unroll") for (int _i = 0; _i < 2; ++_i) \
        __builtin_amdgcn_global_load_lds((const unsigned*)((const char*)(gbase) + (voff)[_i]), (LAS unsigned*)(lds + (bufoff) + ldsw + _i * 8192), 16, 0, 0); } while (0)
#define PG8_LDA(dst, b, h) do { _Pragma("unroll") for (int m = 0; m < 4; ++m) _Pragma("unroll") for (int k = 0; k < 2; ++k) dst[m][k] = *(const LAS bf16x8*)(lds + PG8_SA(b, h) + aoff + m * 2048 + k * 1024); } while (0)
#define PG8_LDB(dst, b, h) do { _Pragma("unroll") for (int n = 0; n < 2; ++n) _Pragma("unroll") for (int k = 0; k < 2; ++k) dst[n][k] = *(const LAS bf16x8*)(lds + PG8_SB(b, h) + boff + n * 2048 + k * 1024); } while (0)
#define PG8_MMA(ai, bj, At, Bt) do { __builtin_amdgcn_s_setprio(1); _Pragma("unroll") for (int m = 0; m < 4; ++m) _Pragma("unroll") for (int n = 0; n < 2; ++n) _Pragma("unroll") for (int k = 0; k < 2; ++k) \
        acc[ai][bj][m][n] = __builtin_amdgcn_mfma_f32_16x16x32_bf16(Bt[n][k], At[m][k], acc[ai][bj][m][n], 0, 0, 0); __builtin_amdgcn_s_setprio(0); } while (0)
#define PG8_WAIT_V(n) asm volatile("s_waitcnt vmcnt(" #n ")" ::: "memory")
#define PG8_WAIT_L(n) asm volatile("s_waitcnt lgkmcnt(" #n ")" ::: "memory")
#define PG8_BAR __builtin_amdgcn_s_barrier()
#define PG8_SCHED __builtin_amdgcn_sched_barrier(0)
    int cpm, cpn, cs, npm = 0, npn = 0, ns = -1, ui = 0;
    if (!S.next(0, cpm, cpn, cs)) return;
    const char* cA = S.pa(Unit{cpm, cpn, cs}); const char* cB = S.pb(Unit{cpm, cpn, cs});
    PG8_STAGE(PG8_SB(0, 0), cB, voffB); PG8_STAGE(PG8_SB(0, 1), cB + hstep, voffB); PG8_STAGE(PG8_SA(0, 0), cA, voffA); PG8_STAGE(PG8_SA(0, 1), cA + hstep, voffA);
    if (wr == 1) PG8_BAR;
    PG8_WAIT_V(2); PG8_BAR;
    PG8_STAGE(PG8_SB(1, 0), cB + kstep, voffB); PG8_STAGE(PG8_SA(1, 0), cA + kstep, voffA); PG8_STAGE(PG8_SB(1, 1), cB + hstep + kstep, voffB);
    PG8_WAIT_V(6); PG8_BAR;
    f32x4 acc[2][2][4][2];
#pragma unroll
    for (int a = 0; a < 2; ++a)
#pragma unroll
        for (int b = 0; b < 2; ++b)
#pragma unroll
            for (int m = 0; m < 4; ++m)
#pragma unroll
                for (int n = 0; n < 2; ++n) acc[a][b][m][n] = (f32x4){0.f, 0.f, 0.f, 0.f};
    bf16x8 At[4][2], B0[2][2], B1[2][2];
    for (;;) {
        const bool has_next = S.next(ui + 1, npm, npn, ns);
        const char* nA = has_next ? S.pa(Unit{npm, npn, ns}) : cA; const char* nB = has_next ? S.pb(Unit{npm, npn, ns}) : cB;
        const int nt = S.nk(Unit{cpm, cpn, cs});
#pragma unroll 1
        for (int t = 0; t < nt; t += 2) {
            const bool last = (t == nt - 2);
            const char* a1 = cA + (size_t)(t + 1) * kstep;
            const char* a2 = last ? nA : cA + (size_t)(t + 2) * kstep; const char* b2 = last ? nB : cB + (size_t)(t + 2) * kstep;
            const char* a3 = a2 + kstep; const char* b3 = b2 + kstep;
            PG8_LDB(B0, 0, 0); PG8_LDB(B1, 0, 1); PG8_SCHED; PG8_LDA(At, 0, 0); PG8_STAGE(PG8_SA(1, 1), a1 + hstep, voffA);
            PG8_WAIT_V(8); PG8_WAIT_L(0); PG8_BAR; PG8_MMA(0, 0, At, B0); PG8_MMA(0, 1, At, B1); PG8_BAR; PG8_SCHED;
            PG8_LDA(At, 0, 1); PG8_STAGE(PG8_SB(0, 0), b2, voffB); PG8_STAGE(PG8_SB(0, 1), b2 + hstep, voffB); PG8_STAGE(PG8_SA(0, 0), a2, voffA);
            PG8_WAIT_V(8); PG8_WAIT_L(0); PG8_BAR; PG8_MMA(1, 0, At, B0); PG8_MMA(1, 1, At, B1); PG8_BAR; PG8_SCHED;
            PG8_LDB(B0, 1, 0); PG8_LDB(B1, 1, 1); PG8_SCHED; PG8_LDA(At, 1, 0); PG8_STAGE(PG8_SA(0, 1), a2 + hstep, voffA);
            PG8_WAIT_V(8); PG8_WAIT_L(0); PG8_BAR; PG8_MMA(0, 0, At, B0); PG8_MMA(0, 1, At, B1); PG8_BAR; PG8_SCHED;
            PG8_LDA(At, 1, 1); PG8_STAGE(PG8_SB(1, 0), b3, voffB); PG8_STAGE(PG8_SB(1, 1), b3 + hstep, voffB); PG8_STAGE(PG8_SA(1, 0), a3, voffA);
            PG8_WAIT_V(8); PG8_WAIT_L(0); PG8_BAR; PG8_MMA(1, 0, At, B0); PG8_MMA(1, 1, At, B1); PG8_BAR; PG8_SCHED;
        }
        if (wr == 0) PG8_BAR;
        E(acc, Unit{cpm, cpn, cs}, wr, wc, fr, fq);
        if (!has_next) break;
#pragma unroll
        for (int a = 0; a < 2; ++a)
#pragma unroll
            for (int b = 0; b < 2; ++b)
#pragma unroll
                for (int m = 0; m < 4; ++m)
#pragma unroll
                    for (int n = 0; n < 2; ++n) acc[a][b][m][n] = (f32x4){0.f, 0.f, 0.f, 0.f};
        cpm = npm; cpn = npn; cs = ns; cA = nA; cB = nB; ++ui;
        if (wr == 1) PG8_BAR;
    }
    PG8_WAIT_V(0);
    PG8_BAR;
#undef PG8_SA
#undef PG8_SB
#undef PG8_STAGE
#undef PG8_LDA
#undef PG8_LDB
#undef PG8_MMA
#undef PG8_WAIT_V
#undef PG8_WAIT_L
#undef PG8_BAR
#undef PG8_SCHED
}

struct EpiAda { static constexpr bool PERM = false; float* mod; const float* bias;
    __device__ __forceinline__ void operator()(const f32x4 (&acc)[2][2][4][2], const Unit& u, int wr, int wc, int fr, int fq) const {
        const int col0 = u.pn * BM + wc * 32 + 4 * fq;
#pragma unroll
        for (int ai = 0; ai < 2; ++ai)
#pragma unroll
            for (int m = 0; m < 4; ++m) { const int row = ai * HALF + wr * 64 + m * 16 + fr;
                if (row < NCB) {
#pragma unroll
                    for (int bj = 0; bj < 2; ++bj)
#pragma unroll
                        for (int n = 0; n < 2; ++n) { const int j = col0 + bj * HALF + n * 16; const int l = j >= 18432 ? 1 : 0, jj = j - l * 18432;
                            *(f32x4*)(mod + ((size_t)l * NCB + row) * 18432 + jj) = acc[ai][bj][m][n] + *(const f32x4*)(bias + j); } } }
    }
};
struct EpiSwiglu { static constexpr bool PERM = true; bf16_t* act;
    __device__ __forceinline__ void operator()(const f32x4 (&acc)[2][2][4][2], const Unit& u, int wr, int wc, int fr, int fq) const {
        const int col0 = u.pn * HALF + wc * 32 + 8 * fq;
#pragma unroll
        for (int ai = 0; ai < 2; ++ai)
#pragma unroll
            for (int m = 0; m < 4; ++m) { const int row = u.pm * BM + ai * HALF + wr * 64 + m * 16 + fr;
                const f32x4 g0 = acc[ai][0][m][0], g1 = acc[ai][0][m][1], u0 = acc[ai][1][m][0], u1 = acc[ai][1][m][1];
                u32x4 w; w.x = cvtpk(siluf_(g0[0]) * u0[0], siluf_(g0[1]) * u0[1]); w.y = cvtpk(siluf_(g0[2]) * u0[2], siluf_(g0[3]) * u0[3]);
                w.z = cvtpk(siluf_(g1[0]) * u1[0], siluf_(g1[1]) * u1[1]); w.w = cvtpk(siluf_(g1[2]) * u1[2], siluf_(g1[3]) * u1[3]);
                *(u32x4*)(act + (size_t)row * FF + col0) = w; }
    }
};
__device__ __forceinline__ void slab_store(const f32x4 (&acc)[2][2][4][2], const Unit& u, int wr, int wc, int fr, int fq, float* slab, int row0, int nrows, int ldc) {
    float* base = slab + (size_t)u.s * ((size_t)nrows * ldc) + u.pn * BM + wc * 32 + 4 * fq;
#pragma unroll
    for (int ai = 0; ai < 2; ++ai)
#pragma unroll
        for (int m = 0; m < 4; ++m) { const int row = u.pm * BM + ai * HALF + wr * 64 + m * 16 + fr - row0;
#pragma unroll
            for (int bj = 0; bj < 2; ++bj)
#pragma unroll
                for (int n = 0; n < 2; ++n) *(f32x4*)(base + (size_t)row * ldc + bj * HALF + n * 16) = acc[ai][bj][m][n]; }
}
__device__ __forceinline__ void slab_store_bf(const f32x4 (&acc)[2][2][4][2], const Unit& u, int wr, int wc, int fr, int fq, bf16_t* slab, int row0, int nrows, int ldc) {
    bf16_t* base = slab + (size_t)u.s * ((size_t)nrows * ldc) + u.pn * BM + wc * 32 + 4 * fq;
#pragma unroll
    for (int ai = 0; ai < 2; ++ai)
#pragma unroll
        for (int m = 0; m < 4; ++m) { const int row = u.pm * BM + ai * HALF + wr * 64 + m * 16 + fr - row0;
#pragma unroll
            for (int bj = 0; bj < 2; ++bj)
#pragma unroll
                for (int n = 0; n < 2; ++n) { const f32x4 v = acc[ai][bj][m][n]; u32x2 w; w.x = cvtpk(v[0], v[1]); w.y = cvtpk(v[2], v[3]);
                    *(u32x2*)(base + (size_t)row * ldc + bj * HALF + n * 16) = w; } }
}
struct EpiDelta { static constexpr bool PERM = false; bf16_t* dl; float* slab;
    __device__ __forceinline__ void operator()(const f32x4 (&acc)[2][2][4][2], const Unit& u, int wr, int wc, int fr, int fq) const {
        if (u.s >= 0) { slab_store_bf(acc, u, wr, wc, fr, fq, (bf16_t*)slab, NPR, NSR, D); return; }
        const int col0 = u.pn * BM + wc * 32 + 4 * fq;
#pragma unroll
        for (int ai = 0; ai < 2; ++ai)
#pragma unroll
            for (int m = 0; m < 4; ++m) { const int row = u.pm * BM + ai * HALF + wr * 64 + m * 16 + fr;
#pragma unroll
                for (int bj = 0; bj < 2; ++bj)
#pragma unroll
                    for (int n = 0; n < 2; ++n) { const f32x4 v = acc[ai][bj][m][n]; u32x2 w; w.x = cvtpk(v[0], v[1]); w.y = cvtpk(v[2], v[3]);
                        *(u32x2*)(dl + (size_t)row * D + col0 + bj * HALF + n * 16) = w; } }
    }
};
struct EpiL2 { static constexpr bool PERM = false; float* dag; const float* w0; const float* a0;
    __device__ __forceinline__ void operator()(const f32x4 (&acc)[2][2][4][2], const Unit& u, int wr, int wc, int fr, int fq) const {
        const int kind = u.pn >> 3, col0 = (u.pn & 7) * BM + wc * 32 + 4 * fq;
        float* base = dag + (size_t)kind * ((size_t)M * D) + col0;
        f32x4 bv[2][2];
#pragma unroll
        for (int bj = 0; bj < 2; ++bj)
#pragma unroll
            for (int n = 0; n < 2; ++n) bv[bj][n] = kind == 0 ? *(const f32x4*)(w0 + col0 + bj * HALF + n * 16) : kind == 1 ? *(const f32x4*)(a0 + col0 + bj * HALF + n * 16) : (f32x4){0.f, 0.f, 0.f, 0.f};
#pragma unroll
        for (int ai = 0; ai < 2; ++ai)
#pragma unroll
            for (int m = 0; m < 4; ++m) { const int row = u.pm * BM + ai * HALF + wr * 64 + m * 16 + fr;
#pragma unroll
                for (int bj = 0; bj < 2; ++bj)
#pragma unroll
                    for (int n = 0; n < 2; ++n) { f32x4 v = acc[ai][bj][m][n] + bv[bj][n];
                        if (kind == 0) {
#pragma unroll
                            for (int e = 0; e < 4; ++e) v[e] = fexp2(-0.60653066f * LOG2E * sigmoidf_(v[e]));
                        } else if (kind == 1) {
#pragma unroll
                            for (int e = 0; e < 4; ++e) v[e] = sigmoidf_(v[e]);
                        }
                        if (kind == 2) { u32x2 w; w.x = cvtpk(v[0], v[1]); w.y = cvtpk(v[2], v[3]); *(u32x2*)((bf16_t*)(dag + (size_t)2 * ((size_t)M * D)) + (size_t)row * D + col0 + bj * HALF + n * 16) = w; }
                        else *(f32x4*)(base + (size_t)row * D + bj * HALF + n * 16) = v; }
                asm volatile("" ::: "memory"); }
    }
};
struct EpiRKV { static constexpr bool PERM = false; float* out; bf16_t* l1;
    __device__ __forceinline__ void operator()(const f32x4 (&acc)[2][2][4][2], const Unit& u, int wr, int wc, int fr, int fq) const {
        if (u.pn >= 24) {
            const int kind = u.pn - 24; bf16_t* base = l1 + (size_t)kind * ((size_t)M * 256) + wc * 32 + 4 * fq;
#pragma unroll
            for (int ai = 0; ai < 2; ++ai)
#pragma unroll
                for (int m = 0; m < 4; ++m) { const int row = u.pm * BM + ai * HALF + wr * 64 + m * 16 + fr;
#pragma unroll
                    for (int bj = 0; bj < 2; ++bj)
#pragma unroll
                        for (int n = 0; n < 2; ++n) { f32x4 v = acc[ai][bj][m][n];
                            if (kind == 0) { v[0] = tanhf_(v[0]); v[1] = tanhf_(v[1]); v[2] = tanhf_(v[2]); v[3] = tanhf_(v[3]); }
                            else if (kind == 2) { v[0] = sigmoidf_(v[0]); v[1] = sigmoidf_(v[1]); v[2] = sigmoidf_(v[2]); v[3] = sigmoidf_(v[3]); }
                            u32x2 w; w.x = cvtpk(v[0], v[1]); w.y = cvtpk(v[2], v[3]);
                            *(u32x2*)(base + (size_t)row * 256 + bj * HALF + n * 16) = w; }
                    asm volatile("" ::: "memory"); }
            return; }
        const int col0 = u.pn * BM + wc * 32 + 4 * fq;
#pragma unroll
        for (int ai = 0; ai < 2; ++ai)
#pragma unroll
            for (int m = 0; m < 4; ++m) { const int row = u.pm * BM + ai * HALF + wr * 64 + m * 16 + fr;
#pragma unroll
                for (int bj = 0; bj < 2; ++bj)
#pragma unroll
                    for (int n = 0; n < 2; ++n) *(f32x4*)(out + (size_t)row * LDR + col0 + bj * HALF + n * 16) = acc[ai][bj][m][n]; }
    }
};
struct EpiF32 { static constexpr bool PERM = false; float* out; int ldc; const float* bias; float* slab; int row0, nrows;
    __device__ __forceinline__ void operator()(const f32x4 (&acc)[2][2][4][2], const Unit& u, int wr, int wc, int fr, int fq) const {
        if (u.s >= 0) { slab_store(acc, u, wr, wc, fr, fq, slab, row0, nrows, ldc); return; }
        const int col0 = u.pn * BM + wc * 32 + 4 * fq;
        f32x4 bv[2][2];
#pragma unroll
        for (int bj = 0; bj < 2; ++bj)
#pragma unroll
            for (int n = 0; n < 2; ++n) bv[bj][n] = bias ? *(const f32x4*)(bias + col0 + bj * HALF + n * 16) : (f32x4){0.f, 0.f, 0.f, 0.f};
#pragma unroll
        for (int ai = 0; ai < 2; ++ai)
#pragma unroll
            for (int m = 0; m < 4; ++m) { const int row = u.pm * BM + ai * HALF + wr * 64 + m * 16 + fr;
#pragma unroll
                for (int bj = 0; bj < 2; ++bj)
#pragma unroll
                    for (int n = 0; n < 2; ++n) *(f32x4*)(out + (size_t)row * ldc + col0 + bj * HALF + n * 16) = acc[ai][bj][m][n] + bv[bj][n]; }
    }
};
}

#define XB_TMO      128
#define XB_XCNT(j)  (256  + 64 * (j))
#define XB_XSUB(j)  (1280 + 64 * (j))
#define XB_XGEN(j)  (2304 + 64 * (j))
#define XB_TOP      3328
#define XB_TOPGEN   3392
#define XCD_BAR_WORDS 3456
#define XB_SPIN_CAP (1u << 18)
__device__ __forceinline__ unsigned xb_ld(unsigned* p)              { return __hip_atomic_load(p, __ATOMIC_RELAXED, __HIP_MEMORY_SCOPE_AGENT); }
__device__ __forceinline__ unsigned xb_add(unsigned* p, unsigned v) { return __hip_atomic_fetch_add(p, v, __ATOMIC_RELAXED, __HIP_MEMORY_SCOPE_AGENT); }
__device__ __forceinline__ unsigned xb_xcc_id() { return (unsigned)__builtin_amdgcn_s_getreg((3 << 11) | 20) & 0xFu; }
#define XB_SPIN(cond, bar) do { unsigned _sp = 0; while (cond) { __builtin_amdgcn_s_sleep(1); \
    if ((++_sp & 255u) == 0u) { if (xb_ld(&(bar)[XB_TMO])) break; if (_sp > XB_SPIN_CAP) { atomicAdd(&(bar)[XB_TMO], 1u); break; } } } } while (0)
struct XcdBarrier { unsigned* bar; unsigned x; volatile LAS unsigned* st; };
__device__ __forceinline__ XcdBarrier xcd_barrier_post(unsigned* bar, volatile LAS unsigned* st) {
    XcdBarrier b; b.bar = bar; b.x = xb_xcc_id(); b.st = st;
    if (threadIdx.x == 0) (void)xb_add(&bar[XB_XCNT(b.x)], 1u);
    return b;
}
__device__ __forceinline__ void xcd_barrier_complete(unsigned* bar, unsigned x, unsigned& nloc, unsigned& nx) {
    const unsigned G = gridDim.x * gridDim.y * gridDim.z;
    unsigned sum, cnt, mine, sp = 0u;
    for (;;) {
        sum = 0u; cnt = 0u; mine = 0u;
#pragma unroll
        for (unsigned j = 0; j < 16; ++j) { const unsigned c = xb_ld(&bar[XB_XCNT(j)]); sum += c; cnt += (c > 0u) ? 1u : 0u; mine = (j == x) ? c : mine; }
        if (sum == G) break;
        __builtin_amdgcn_s_sleep(1);
        if ((++sp & 255u) == 0u) { if (xb_ld(&bar[XB_TMO])) break; if (sp > XB_SPIN_CAP) { atomicAdd(&bar[XB_TMO], 1u); break; } }
    }
    nloc = mine > 0u ? mine : 1u; nx = cnt > 0u ? cnt : 1u;
}
__device__ __forceinline__ void xcd_barrier(const XcdBarrier& b) {
    asm volatile("s_waitcnt vmcnt(0)" ::: "memory");
    __syncthreads();
    if (threadIdx.x == 0) {
        unsigned* bar = b.bar;
        __builtin_amdgcn_s_waitcnt(0);
        unsigned nloc = b.st[0], nx = b.st[1];
        if (nloc == 0u) { xcd_barrier_complete(bar, b.x, nloc, nx); b.st[0] = nloc; b.st[1] = nx; }
        const unsigned old = xb_add(&bar[XB_XSUB(b.x)], 1u);
        const unsigned gen = old / nloc;
        if (old + 1u == (gen + 1u) * nloc) {
            __builtin_amdgcn_fence(__ATOMIC_RELEASE, "agent");
            asm volatile("s_waitcnt vmcnt(0)" ::: "memory");
            const unsigned og = xb_add(&bar[XB_TOP], 1u);
            const unsigned tg = og / nx;
            if (og + 1u == (tg + 1u) * nx) xb_add(&bar[XB_TOPGEN], 1u);
            else XB_SPIN(xb_ld(&bar[XB_TOPGEN]) == tg, bar);
            __builtin_amdgcn_fence(__ATOMIC_ACQUIRE, "agent");
            xb_add(&bar[XB_XGEN(b.x)], 1u);
            asm volatile("s_waitcnt vmcnt(0)" ::: "memory");
        } else {
            XB_SPIN(xb_ld(&bar[XB_XGEN(b.x)]) == gen, bar);
            __builtin_amdgcn_fence(__ATOMIC_ACQUIRE, "agent");
            asm volatile("s_waitcnt vmcnt(0)" ::: "memory");
        }
    }
    __syncthreads();
}

__constant__ __attribute__((aligned(16))) float INV_FREQ[32] = {
    1.0f, 0.7498942093324559f, 0.5623413251903491f, 0.4216965034285822f, 0.31622776601683794f, 0.23713737056616552f, 0.1778279410038923f, 0.1333521432163324f,
    0.1f, 0.07498942093324558f, 0.05623413251903491f, 0.04216965034285822f, 0.03162277660168379f, 0.023713737056616554f, 0.01778279410038923f, 0.01333521432163324f,
    0.01f, 0.007498942093324558f, 0.005623413251903491f, 0.004216965034285822f, 0.0031622776601683794f, 0.0023713737056616554f, 0.001778279410038923f, 0.001333521432163324f,
    0.001f, 0.0007498942093324559f, 0.0005623413251903491f, 0.0004216965034285822f, 0.00031622776601683794f, 0.00023713737056616554f, 0.0001778279410038923f, 0.0001333521432163324f};

__device__ __forceinline__ void transpose_item(const float* W, int N, bf16_t* WT, int Kd, int k0, int n0, int drow0, LAS float* scr, int lane) {
    {
        const int kr = lane >> 3, n4 = (lane & 7) * 4; f32x4 v[8];
#pragma unroll
        for (int i = 0; i < 8; ++i) v[i] = *(const f32x4*)(W + (size_t)(k0 + 8 * i + kr) * N + n0 + n4);
#pragma unroll
        for (int i = 0; i < 8; ++i) { LAS float* d = scr + (8 * i + kr) * 33 + n4; d[0] = v[i].x; d[1] = v[i].y; d[2] = v[i].z; d[3] = v[i].w; }
    }
    LDS_WAIT(); asm volatile("" ::: "memory");
    const int c = lane & 7;
#pragma unroll
    for (int j = 0; j < 4; ++j) { const int n = (lane >> 3) + 8 * j; const LAS float* s = scr + (8 * c) * 33 + n;
        u32x4 o; o.x = cvtpk(s[0 * 33], s[1 * 33]); o.y = cvtpk(s[2 * 33], s[3 * 33]); o.z = cvtpk(s[4 * 33], s[5 * 33]); o.w = cvtpk(s[6 * 33], s[7 * 33]);
        __builtin_nontemporal_store(o, (GAS u32x4*)(WT + (size_t)(drow0 + n) * Kd + k0 + 8 * c)); }
    LDS_WAIT(); asm volatile("" ::: "memory");
}

struct Pend { const float* slab; int S; const float* gate; const float* bias; float mul; };
__device__ __forceinline__ void load_x_row(const void* xrow, bool xbf, int lane, f32x4 (&h)[8], const Pend& pd) {
    if (xbf) {
#pragma unroll
        for (int j = 0; j < 8; ++j) { const u32x2 w = ((const u32x2*)xrow)[lane + 64 * j];
            h[j] = (f32x4){bf2f((unsigned short)(w.x & 0xffffu)), bf2f((unsigned short)(w.x >> 16)), bf2f((unsigned short)(w.y & 0xffffu)), bf2f((unsigned short)(w.y >> 16))}; }
    } else {
#pragma unroll
        for (int j = 0; j < 8; ++j) h[j] = ((const f32x4*)xrow)[lane + 64 * j];
    }
    if (pd.slab) {
        f32x4 a[8];
#pragma unroll
        for (int j = 0; j < 8; ++j) a[j] = pd.bias ? ((const f32x4*)pd.bias)[lane + 64 * j] : (f32x4){0.f, 0.f, 0.f, 0.f};
        if (pd.S == 0) {
#pragma unroll
            for (int j = 0; j < 8; ++j) { const u32x2 w = ((const u32x2*)pd.slab)[lane + 64 * j];
                a[j] = a[j] + (f32x4){bf2f((unsigned short)(w.x & 0xffffu)), bf2f((unsigned short)(w.x >> 16)), bf2f((unsigned short)(w.y & 0xffffu)), bf2f((unsigned short)(w.y >> 16))}; }
        } else {
#pragma unroll 2
            for (int s = 0; s < pd.S; ++s) { f32x4 t[8];
#pragma unroll
                for (int j = 0; j < 8; ++j) t[j] = bf4(((const u32x2*)((const bf16_t*)pd.slab + (size_t)s * ((size_t)NSR * D)))[lane + 64 * j]);
#pragma unroll
                for (int j = 0; j < 8; ++j) a[j] = a[j] + t[j]; }
        }
#pragma unroll
        for (int j = 0; j < 8; ++j) h[j] = h[j] + (((const f32x4*)pd.gate)[lane + 64 * j] * pd.mul) * a[j];
    }
}
__device__ __forceinline__ void norm_mod_row(const void* xrow, bool xbf, const float* g, const float* shift, const float* scale, int lane, f32x4 (&h)[8], bf16_t* xcopy, const Pend& pd) {
    float ss = 0.f;
    load_x_row(xrow, xbf, lane, h, pd);
#pragma unroll
    for (int j = 0; j < 8; ++j) ss += (h[j].x * h[j].x + h[j].y * h[j].y) + (h[j].z * h[j].z + h[j].w * h[j].w);
    if (xcopy) {
#pragma unroll
        for (int j = 0; j < 8; ++j) { u32x2 w; w.x = cvtpk(h[j].x, h[j].y); w.y = cvtpk(h[j].z, h[j].w); __builtin_nontemporal_store(w, (u32x2*)xcopy + lane + 64 * j); }
    }
    ss = wave_sum(ss);
    const float rs = 1.0f / sqrtf(ss * (1.0f / D) + RMS_EPS);
#pragma unroll
    for (int j = 0; j < 8; ++j) { const f32x4 g4 = ((const f32x4*)g)[lane + 64 * j], sc = ((const f32x4*)scale)[lane + 64 * j], sh = ((const f32x4*)shift)[lane + 64 * j];
        h[j] = (h[j] * rs * g4) * (1.0f + sc) + sh; }
}
__device__ __forceinline__ void store_bf16_row(bf16_t* orow, const f32x4 (&h)[8], int lane) {
#pragma unroll
    for (int j = 0; j < 8; ++j) { u32x2 w; w.x = cvtpk(h[j].x, h[j].y); w.y = cvtpk(h[j].z, h[j].w); __builtin_nontemporal_store(w, (u32x2*)orow + lane + 64 * j); }
}

__device__ __forceinline__ void scan_step(f32x4& S, const f32x4 w, const f32x4 kk, const f32x4 kka, const f32x4 kp, const f32x4 r, const float vv, float& y) {
    float p = S.x * kk.x; p = fmaf(S.y, kk.y, p); p = fmaf(S.z, kk.z, p); p = fmaf(S.w, kk.w, p);
    p = row16_sum(p);
    S.x = fmaf(S.x, w.x, fmaf(-p, kka.x, vv * kp.x)); S.y = fmaf(S.y, w.y, fmaf(-p, kka.y, vv * kp.y));
    S.z = fmaf(S.z, w.z, fmaf(-p, kka.z, vv * kp.z)); S.w = fmaf(S.w, w.w, fmaf(-p, kka.w, vv * kp.w));
    float q = S.x * r.x; q = fmaf(S.y, r.y, q); q = fmaf(S.z, r.z, q); q = fmaf(S.w, r.w, q);
    y = row16_sum(q);
}
__device__ __forceinline__ void rwkv_derive(const f32x4 k4, const f32x4 a4, const f32x4 kkw, const f32x4 kaw, f32x4& kk, f32x4& kka, f32x4& kp) {
    kk = k4 * kkw; float ss = (kk.x * kk.x + kk.y * kk.y) + (kk.z * kk.z + kk.w * kk.w); ss = row16_sum(ss);
    const float inv = __builtin_amdgcn_rsqf(fmaxf(ss, 1e-24f));
    kk = kk * inv; kka = kk * a4; kp = k4 * (1.0f + (a4 - 1.0f) * kaw);
}

struct Args { const float* in[35]; float* out; unsigned char* ws; int ph_lo, ph_hi; };

#define x_prompt (ap->in[0])
#define x_sample (ap->in[1])
#define st_wkv (ap->in[2])
#define st_shift (ap->in[3])
#define cache_k (ap->in[4])
#define cache_v (ap->in[5])
#define c_prompt (ap->in[6])
#define c_sample (ap->in[7])
#define norm_g (ap->in[8])
#define w_ada (ap->in[9])
#define b_ada (ap->in[10])
#define w_ffn_in (ap->in[11])
#define w_ffn_out (ap->in[12])
#define rw_mu (ap->in[13])
#define rw_wrkv (ap->in[14])
#define rw_w0 (ap->in[15])
#define rw_w1 (ap->in[16])
#define rw_w2 (ap->in[17])
#define rw_a0 (ap->in[18])
#define rw_a1 (ap->in[19])
#define rw_a2 (ap->in[20])
#define rw_g1 (ap->in[21])
#define rw_g2 (ap->in[22])
#define rw_kk (ap->in[23])
#define rw_ka (ap->in[24])
#define rw_rk (ap->in[25])
#define rw_gn_w (ap->in[26])
#define rw_gn_b (ap->in[27])
#define rw_wo (ap->in[28])
#define sw_wqkv (ap->in[29])
#define sw_bqkv (ap->in[30])
#define sw_sink (ap->in[31])
#define sw_wo (ap->in[32])
#define sw_bo (ap->in[33])
#define final_g (ap->in[34])
#define W_ADA ((bf16_t*)(ap->ws + WS_WADA))
#define W_FIN ((bf16_t*)(ap->ws + WS_WFIN))
#define W_FOUT ((bf16_t*)(ap->ws + WS_WFOUT))
#define W_RKVL1 ((bf16_t*)(ap->ws + WS_WRKVL1))
#define W_L2 ((bf16_t*)(ap->ws + WS_WL2))
#define W_RWO ((bf16_t*)(ap->ws + WS_WRWO))
#define W_QKV ((bf16_t*)(ap->ws + WS_WQKV))
#define W_SWO ((bf16_t*)(ap->ws + WS_WSWO))
#define CS ((bf16_t*)(ap->ws + WS_CS))
#define MOD ((float*)(ap->ws + WS_MOD))
#define X ((float*)(ap->ws + WS_X))
#define HA ((bf16_t*)(ap->ws + WS_HA))
#define ACT ((bf16_t*)(ap->ws + WS_ACT))
#define XA6 ((bf16_t*)(ap->ws + WS_XA6))
#define DAG ((float*)(ap->ws + WS_DAG))
#define RKV ((float*)(ap->ws + WS_RKV))
#define L1OUT ((bf16_t*)(ap->ws + WS_L1OUT))
#define YRAW ((float*)(ap->ws + WS_YRAW))
#define QKV ((float*)(ap->ws + WS_QKV))
#define QB ((bf16_t*)(ap->ws + WS_QB))
#define KB ((bf16_t*)(ap->ws + WS_KB))
#define VB ((bf16_t*)(ap->ws + WS_VB))
#define SLAB ((float*)(ap->ws + WS_SLAB))
#define DELTA ((float*)(ap->ws + WS_DELTA))
#define XBUF(i_) ((bf16_t*)(ap->ws + ((i_) ? WS_X2 : WS_X)))
#define out (ap->out)
#define BONUS ((float*)(ap->ws + WS_L1OUT))

#define MAKE_PEND(pd_, m_, b_, S_, modl_, slot_, bias_, mul_) do { pd_.slab = (m_) < NPR ? (const float*)((const bf16_t*)DELTA + (size_t)(m_) * D) : (const float*)((const bf16_t*)SLAB + (size_t)((m_) - NPR) * D); pd_.S = (m_) < NPR ? 0 : (S_); \
    pd_.gate = MOD + (size_t)(modl_) * NCB * NMOD * D + (size_t)(b_) * NMOD * D + (size_t)(slot_) * D; pd_.bias = (bias_); pd_.mul = (mul_); } while (0)
typedef const __attribute__((address_space(4))) Args* ArgsP;
__global__ void __launch_bounds__(NTHREADS, 2) mk_fwd(Args args) {
    extern __shared__ __attribute__((aligned(16))) unsigned char lds_raw[];
    LAS unsigned char* lds0 = (LAS unsigned char*)lds_raw;
    volatile LAS unsigned* MISC = (volatile LAS unsigned*)(lds0 + MISC_OFF);
    for (int u = threadIdx.x; u < (LDS_BYTES - LDSCTL_OFF) / 4; u += NTHREADS) ((LAS unsigned*)(lds0 + LDSCTL_OFF))[u] = 0u;
    __syncthreads();
    (void)xcd_barrier_post((unsigned*)(args.ws + WS_CTL) + CW_BAR, MISC + 8);
#define PH_SETUP ArgsP ap; { ArgsP p_ = (ArgsP)__builtin_amdgcn_kernarg_segment_ptr(); asm volatile("" : "+s"(p_)); ap = p_; } \
    int tid = threadIdx.x; asm volatile("" : "+v"(tid)); const int lane = tid & 63, wave = __builtin_amdgcn_readfirstlane(tid >> 6); \
    int G = gridDim.x; asm volatile("" : "+s"(G)); int bx = blockIdx.x; asm volatile("" : "+s"(bx)); const int vcu = (G % 8 == 0) ? (bx % 8) * (G / 8) + bx / 8 : bx; const int gw = vcu * NWAVES + wave, NGW = G * NWAVES; \
    unsigned ldsz_ = 0u; asm volatile("" : "+s"(ldsz_)); LAS unsigned char* lds = lds0 + ldsz_; \
    (void)lane; (void)gw; (void)NGW; (void)vcu; (void)lds;
#define PH_BARRIER do { XcdBarrier b_; { ArgsP p_ = (ArgsP)__builtin_amdgcn_kernarg_segment_ptr(); asm volatile("" : "+s"(p_)); b_.bar = (unsigned*)(p_->ws + WS_CTL) + CW_BAR; } b_.x = xb_xcc_id(); b_.st = MISC + 8; xcd_barrier(b_); } while (0)
#if MK_PER_PHASE
    const int lo = args.ph_lo, hi = args.ph_hi; int pc = 0;
#define PH_BEGIN if (pc >= lo && pc < hi) { PH_SETUP
#define PH_END } ++pc;
#else
#define PH_BEGIN { PH_SETUP
#define PH_END } PH_BARRIER;
#endif
#define PH_END_LAST }

#define QPOP(it_) do { unsigned q_ = 0u; if (lane == 0) q_ = __hip_atomic_fetch_add(qc, 1u, __ATOMIC_RELAXED, __HIP_MEMORY_SCOPE_WORKGROUP); it_ = (int)__builtin_amdgcn_readfirstlane(q_); } while (0)
#define QROWS_SETUP LAS unsigned* qc = (LAS unsigned*)(lds + QCTR_OFF) + qslot; const int qs0 = (vcu * NSR) / G, qns = ((vcu + 1) * NSR) / G - qs0, qnit = qns + NWAVES * ((NPR + NGW - 1) / NGW);
#define QROW(it_) ((it_) < qns ? NPR + qs0 + (it_) : NWAVES * vcu + (((it_) - qns) & (NWAVES - 1)) + NGW * (((it_) - qns) / NWAVES))
#define QSKIP(it_, m_) ((it_) >= qns && (m_) >= NPR)
    int qslot = 0;
    int xcur = 0;
    PH_BEGIN
    {
        LAS float* scr = (LAS float*)(lds + wave * 16384);
        for (int jobi = 0; jobi < 16; ++jobi) { const int job = (jobi + 2) & 15;
            if (G == 256 && (job == 9 || job == 14 || job == 15)) continue;
            const float* W; int K_, N_; bf16_t* WT; int mode = 0, roff = 0;
            if (job < 2) { W = w_ada + (size_t)job * D * 18432; K_ = D; N_ = 18432; WT = W_ADA; roff = job * 18432; }
            else if (job < 6) { W = w_ffn_in + (size_t)(job - 2) * D * (2 * FF); K_ = D; N_ = 2 * FF; WT = W_FIN + (size_t)(job - 2) * (2 * FF) * D; mode = 1; }
            else if (job < 10) { W = w_ffn_out + (size_t)(job - 6) * FF * D; K_ = FF; N_ = D; WT = W_FOUT + (size_t)(job - 6) * D * FF; }
            else if (job < 13) { W = rw_wrkv + (size_t)(job - 10) * D * D; K_ = D; N_ = D; WT = W_RKVL1; roff = (job - 10) * D; }
            else if (job == 13) { W = rw_wo; K_ = D; N_ = D; WT = W_RWO; }
            else if (job == 14) { W = sw_wqkv; K_ = D; N_ = QKVW; WT = W_QKV; }
            else { W = sw_wo; K_ = D; N_ = D; WT = W_SWO; }
            const int nblk = N_ / 32, nitems = (K_ / 64) * nblk;
            for (int it = gw; it < nitems; it += NGW) { const int kb = it / nblk, nb = it % nblk, n0 = 32 * nb;
                int drow0 = roff + n0;
                if (mode == 1) { const int up = n0 >= FF ? 1 : 0, jj = n0 - up * FF; drow0 = 256 * (jj >> 7) + 128 * up + (jj & 127); }
                transpose_item(W, N_, WT, K_, 64 * kb, n0, drow0, scr, lane); }
        }
        const int gt = gw * 64 + lane, NGT = NGW * 64;
        for (int idx = gt; idx < 768 * 2048; idx += NGT) { const int n = idx >> 11, k = idx & 2047, i = n >> 8, nn = n & 255;
            const float* src = i == 0 ? rw_w1 : i == 1 ? rw_a1 : rw_g1; const int Ni = i == 2 ? 256 : 96;
            const float v = nn < Ni ? src[(size_t)k * Ni + nn] : 0.f; W_RKVL1[(size_t)(6144 + n) * D + k] = (bf16_t)(cvtpk(v, 0.f) & 0xffffu); }
        for (int idx = gt; idx < 6144 * 256; idx += NGT) { const int n = idx >> 8, k = idx & 255, i = n >> 11, nn = n & 2047;
            const float* src = i == 0 ? rw_w2 : i == 1 ? rw_a2 : rw_g2; const int Ki = i == 2 ? 256 : 96;
            const float v = k < Ki ? src[(size_t)k * D + nn] : 0.f; W_L2[(size_t)n * 256 + k] = (bf16_t)(cvtpk(v, 0.f) & 0xffffu); }
        for (int idx = gt; idx < 256 * D; idx += NGT) { const int r = idx >> 11, k = idx & 2047;
            float v = 0.f; if (r < 2) v = siluf_(c_prompt[r * D + k]); else if (r < NCB) v = siluf_(c_sample[(r - 2) * D + k]);
            CS[idx] = (bf16_t)(cvtpk(v, 0.f) & 0xffffu); }
    }
    PH_END

    PH_BEGIN
    {
        pg8::Sched<pg8::ASel0, pg8::SplitOrder<1, 144, 32, 1, 1>> S; S.ord.init(G, bx); S.A = (const char*)CS; S.Bt = (const char*)W_ADA; S.tstep = (size_t)256 * D * 2; S.astride = 0;
        pg8::EpiAda E{MOD, b_ada};
        pg8::gemm_phase(lds, tid, D, S, E);
        if (G == 256 && bx >= 144) {
            LAS float* scr = (LAS float*)(lds + wave * 16384);
            const int gwi = (bx - 144) * NWAVES + wave, NGI = (256 - 144) * NWAVES;
            for (int jq = 0; jq < 3; ++jq) {
                const float* W; int K_, N_; bf16_t* WT;
                if (jq == 0) { W = w_ffn_out + (size_t)3 * FF * D; K_ = FF; N_ = D; WT = W_FOUT + (size_t)3 * D * FF; }
                else if (jq == 1) { W = sw_wqkv; K_ = D; N_ = QKVW; WT = W_QKV; }
                else { W = sw_wo; K_ = D; N_ = D; WT = W_SWO; }
                const int nblk = N_ / 32, nitems = (K_ / 64) * nblk;
                for (int it = gwi; it < nitems; it += NGI) { const int kb = it / nblk, nb = it % nblk, n0 = 32 * nb;
                    transpose_item(W, N_, WT, K_, 64 * kb, n0, n0, scr, lane); }
            }
        }
    }
    PH_END

    for (int layer = 0; layer < 2; ++layer) {
        for (int sub = 0; sub < 3; ++sub) {
            if (sub != 1) {
                const int fi = layer * 2 + (sub >> 1);
                PH_BEGIN
                {
                    const bool first = (layer == 0 && sub == 0);
                    QROWS_SETUP
                    for (;;) { int it; QPOP(it); if (it >= qnit) break; const int m = QROW(it); if (QSKIP(it, m)) continue; const int b = bidx_of_row(m);
                        const void* xrow = first ? (const void*)(m < NPR ? x_prompt + (size_t)m * D : x_sample + (size_t)(m - NPR) * D) : (const void*)(XBUF(xcur) + (size_t)m * D);
                        const float* mb = (MOD + (size_t)layer * NCB * NMOD * D) + (size_t)b * NMOD * D + (size_t)(3 * sub) * D;
                        Pend pd{nullptr, 0, nullptr, nullptr, 0.f};
                        if (!first) { if (sub == 0) MAKE_PEND(pd, m, b, 11, layer - 1, 8, nullptr, 0.5f); else MAKE_PEND(pd, m, b, 8, layer, 5, (layer == 0 ? nullptr : sw_bo), 1.0f); }
                        f32x4 h[8]; if (first) norm_mod_row(xrow, false, (norm_g + (size_t)(layer * 3 + sub) * D), mb, mb + D, lane, h, XBUF(xcur) + (size_t)m * D, pd); else norm_mod_row(xrow, true, (norm_g + (size_t)(layer * 3 + sub) * D), mb, mb + D, lane, h, XBUF(xcur ^ 1) + (size_t)m * D, pd);
                        store_bf16_row(HA + (size_t)m * D, h, lane); }
                }
                PH_END
                ++qslot;
                if (!(layer == 0 && sub == 0)) xcur ^= 1;
                PH_BEGIN
                {
                    pg8::Sched<pg8::ASel0, pg8::SplitOrder<34, 44, 32, 34, 1>> S; S.ord.init(G, bx); S.A = (const char*)HA; S.Bt = (const char*)(W_FIN + (size_t)fi * (2 * FF) * D); S.tstep = (size_t)256 * D * 2; S.astride = 0;
                    pg8::EpiSwiglu E{ACT};
                    pg8::gemm_phase(lds, tid, D, S, E);
                }
                PH_END
                PH_BEGIN
                {
                    pg8::Sched<pg8::ASel0, pg8::SplitOrder<34, 8, 88, 32, 11>> S; S.ord.init(G, bx); S.A = (const char*)ACT; S.Bt = (const char*)(W_FOUT + (size_t)fi * D * FF); S.tstep = (size_t)256 * FF * 2; S.astride = 0;
                    pg8::EpiDelta E{(bf16_t*)DELTA, SLAB};
                    pg8::gemm_phase(lds, tid, FF, S, E);
                }
                PH_END
            } else if (layer == 0) {
                PH_BEGIN
                {
                    LAS unsigned* qc = (LAS unsigned*)(lds + QCTR_OFF) + qslot;
                    const int wg = (G == 256) ? 12 : 0, g0 = (vcu * 128) / G, g1 = ((vcu + 1) * 128) / G, nsg = g1 - g0;
                    const int p0 = wg ? 38 * vcu - wg * g0 : (vcu * NPR) / G, p1 = wg ? 38 * (vcu + 1) - wg * g1 : ((vcu + 1) * NPR) / G;
                    const int wav = (NWAVES - nsg) > 1 ? (NWAVES - nsg) : 1, chunk = ((p1 - p0) + wav - 1) / wav > 1 ? ((p1 - p0) + wav - 1) / wav : 1, nitq = nsg + ((p1 - p0) + chunk - 1) / chunk;
                    for (;;) { int it; QPOP(it); if (it >= nitq) break;
                        int m0, n, t0, sidx = 0; if (it >= nsg) { m0 = p0 + chunk * (it - nsg); n = (p1 - m0) < chunk ? (p1 - m0) : chunk; t0 = m0 & 4095; } else { sidx = g0 + it; m0 = NPR + 4 * sidx; n = 4; t0 = 0; }
                        const int b = bidx_of_row(m0); const float* mb = (MOD + (size_t)layer * NCB * NMOD * D) + (size_t)b * NMOD * D + 3 * D;
                        f32x4 prev[8], h[8];
                        if (t0 == 0) {
                            if (m0 < NPR) {
#pragma unroll
                                for (int j = 0; j < 8; ++j) prev[j] = (f32x4){0.f, 0.f, 0.f, 0.f};
                            } else {
#pragma unroll
                                for (int j = 0; j < 8; ++j) prev[j] = ((const f32x4*)(st_shift + (size_t)sidx * D))[lane + 64 * j];
                            }
                        } else { Pend pd0{nullptr, 0, nullptr, nullptr, 0.f}; MAKE_PEND(pd0, m0 - 1, b, 11, layer, 2, nullptr, 0.5f); norm_mod_row(XBUF(xcur) + (size_t)(m0 - 1) * D, true, (norm_g + (size_t)(layer * 3 + sub) * D), mb, mb + D, lane, prev, nullptr, pd0); }
                        for (int r = 0; r < n; ++r) { const int m = m0 + r;
                            if (G != 256 && r > 0 && m < NPR && (m & 4095) == 0) {
#pragma unroll
                                for (int j = 0; j < 8; ++j) prev[j] = (f32x4){0.f, 0.f, 0.f, 0.f}; }
                            const int bm = bidx_of_row(m); const float* mbm = (MOD + (size_t)layer * NCB * NMOD * D) + (size_t)bm * NMOD * D + 3 * D;
                            Pend pd{nullptr, 0, nullptr, nullptr, 0.f}; MAKE_PEND(pd, m, bm, 11, layer, 2, nullptr, 0.5f);
                            norm_mod_row(XBUF(xcur) + (size_t)m * D, true, (norm_g + (size_t)(layer * 3 + sub) * D), mbm, mbm + D, lane, h, XBUF(xcur ^ 1) + (size_t)m * D, pd);
#pragma unroll 1
                            for (int i = 0; i < 6; ++i) { bf16_t* orow = XA6 + (size_t)i * M * D + (size_t)m * D; const int mi = (i == 1) ? 2 : (i == 2) ? 3 : (i == 3) ? 1 : i;
#pragma unroll
                                for (int j = 0; j < 8; ++j) { const f32x4 mu = ((const f32x4*)(rw_mu + mi * D))[lane + 64 * j]; const f32x4 v = h[j] + (prev[j] - h[j]) * mu;
                                    u32x2 w; w.x = cvtpk(v.x, v.y); w.y = cvtpk(v.z, v.w); __builtin_nontemporal_store(w, (u32x2*)orow + lane + 64 * j); } }
                            const bool lastp = (m < NPR) && ((m & 4095) == 4095), lasts = (m >= NPR) && (r == 3);
                            if (lastp || lasts) { float* so = lastp ? out + O_PSHIFT + (size_t)bm * D : out + O_SSHIFT + (size_t)sidx * D;
#pragma unroll
                                for (int j = 0; j < 8; ++j) ((f32x4*)so)[lane + 64 * j] = h[j]; }
#pragma unroll
                            for (int j = 0; j < 8; ++j) prev[j] = h[j];
                        }
                    }
                }
                PH_END
                ++qslot;
                xcur ^= 1;
                PH_BEGIN
                {
                    pg8::Sched<pg8::ASelRKV, pg8::SplitOrder<34, 27, 32, 34, 1>> S; S.ord.init(G, bx); S.A = (const char*)XA6; S.Bt = (const char*)W_RKVL1; S.tstep = (size_t)256 * D * 2; S.astride = (size_t)M * D * 2;
                    pg8::EpiRKV E{RKV, L1OUT};
                    pg8::gemm_phase(lds, tid, D, S, E);
                }
                PH_END
                PH_BEGIN
                {
                    pg8::Sched<pg8::ASelL2, pg8::SplitOrder<34, 24, 4, 34, 1>> S; S.ord.init(G, bx); S.A = (const char*)L1OUT; S.Bt = (const char*)W_L2; S.tstep = (size_t)256 * 256 * 2; S.astride = (size_t)M * 256 * 2;
                    pg8::EpiL2 E{DAG, rw_w0, rw_a0};
                    pg8::gemm_phase(lds, tid, 256, S, E);
                }
                PH_END
                PH_BEGIN
                {
                    const float* Rr = RKV; const float* Kk = RKV + D; const float* Vv = RKV + 2 * D;
                    const float* Dec = DAG; const float* Aa = DAG + (size_t)M * D;
                    const int rg = lane >> 4, kq = lane & 15;
#define SAMPLE_TASK(task_) do { const int stk_ = (task_); \
                        const int bs = stk_ >> 9, hs_ = (stk_ >> 4) & 31, rq = stk_ & 15, srow = 4 * rq + rg, scol = hs_ * 64 + 4 * kq; \
                        const f32x4 kkw_ = *(const f32x4*)(rw_kk + scol), kaw_ = *(const f32x4*)(rw_ka + scol); \
                        const size_t so = (((size_t)bs * NH + hs_) * 64 + srow) * 64 + 4 * kq; \
                        f32x4 Ss = *(const f32x4*)(st_wkv + so); \
                        _Pragma("unroll") for (int t = 0; t < DEC_T; ++t) { const size_t o = ((size_t)NPR + 4 * bs + t) * D + scol, o2 = ((size_t)NPR + 4 * bs + t) * LDR + scol; \
                            const f32x4 k4 = *(const f32x4*)(Kk + o2), a4 = *(const f32x4*)(Aa + o), w4 = *(const f32x4*)(Dec + o), r4 = *(const f32x4*)(Rr + o2); \
                            const float vv = Vv[((size_t)NPR + 4 * bs + t) * LDR + hs_ * 64 + srow]; \
                            f32x4 kk, kka, kp; rwkv_derive(k4, a4, kkw_, kaw_, kk, kka, kp); float y; \
                            scan_step(Ss, w4, kk, kka, kp, r4, vv, y); \
                            if (kq == 0) YRAW[((size_t)NPR + 4 * bs + t) * D + hs_ * 64 + srow] = y; } \
                        *(f32x4*)(out + O_SWKV + so) = Ss; } while (0)
#define SAMPLE_ISSUE(task_) do { const int stk_ = (task_); sp_bs = stk_ >> 9; sp_h = (stk_ >> 4) & 31; sp_row = 4 * (stk_ & 15) + rg; const int scol = sp_h * 64 + 4 * kq; \
                        sp_so = (((size_t)sp_bs * NH + sp_h) * 64 + sp_row) * 64 + 4 * kq; sp_S = *(const f32x4*)(st_wkv + sp_so); sp_kkw = *(const f32x4*)(rw_kk + scol); sp_kaw = *(const f32x4*)(rw_ka + scol); \
                        _Pragma("unroll") for (int t = 0; t < DEC_T; ++t) { const size_t o = ((size_t)NPR + 4 * sp_bs + t) * D + scol, o2 = ((size_t)NPR + 4 * sp_bs + t) * LDR + scol; \
                            sp_k[t] = *(const f32x4*)(Kk + o2); sp_a[t] = *(const f32x4*)(Aa + o); sp_w[t] = *(const f32x4*)(Dec + o); sp_r[t] = *(const f32x4*)(Rr + o2); \
                            sp_v[t] = Vv[((size_t)NPR + 4 * sp_bs + t) * LDR + sp_h * 64 + sp_row]; } sp_pending = true; } while (0)
#define SAMPLE_FINISH() do { if (sp_pending) { \
                        _Pragma("unroll") for (int t = 0; t < DEC_T; ++t) { f32x4 kk, kka, kp; rwkv_derive(sp_k[t], sp_a[t], sp_kkw, sp_kaw, kk, kka, kp); float y; \
                            scan_step(sp_S, sp_w[t], kk, kka, kp, sp_r[t], sp_v[t], y); \
                            if (kq == 0) YRAW[((size_t)NPR + 4 * sp_bs + t) * D + sp_h * 64 + sp_row] = y; } \
                        *(f32x4*)(out + O_SWKV + sp_so) = sp_S; sp_pending = false; } } while (0)
                    constexpr int CH = 16, NCH = SEQ / CH;
                    constexpr int SLOTB = 16384, O_KT = 0, O_RT = 2304, O_BT = 4608, O_KL = 6912, O_KH = 9216, O_BH = 11264, O_VT = 13312, O_GAM = 13824, O_AKK = 14080, O_AKR = 14592, O_ABR = 15104, O_ABK = 15616, O_DG = 16128;
#define BF1(x_) ((unsigned short)(cvtpk((x_), 0.f) & 0xffffu))
#define STEP_BARRIER() asm volatile("s_waitcnt lgkmcnt(0)\n\ts_barrier" ::: "memory")
                    for (int task = vcu; task < 256; task += G) {
                        const int bh = task >> 2, cq = task & 3, b = bh >> 5, hh = bh & 31;
                        const size_t rowbase = (size_t)b * SEQ;
                        if (wave >= 4) {
                            const int lw = wave - 4, t = lane >> 2, kq4 = lane & 3, kc = 16 * lw + 4 * kq4, col = hh * 64 + kc, rho = lane >> 4;
                            const f32x4 kkw_o = *(const f32x4*)(rw_kk + col), kaw_o = *(const f32x4*)(rw_ka + col);
                            LAS float* ssq = (LAS float*)(lds + 3 * SLOTB + 4096);
                            f32x4 Lk[4], La[4], Lw[4], Lr[4], Lv[4];
#define L_ISSUE(c_, q_) do { const size_t mrow = rowbase + (size_t)(c_) * CH + t; const size_t o = mrow * D + col, o2 = mrow * LDR + col; \
                                Lk[q_] = *(const f32x4*)(Kk + o2); La[q_] = *(const f32x4*)(Aa + o); Lw[q_] = *(const f32x4*)(Dec + o); Lr[q_] = *(const f32x4*)(Rr + o2); \
                                Lv[q_] = *(const f32x4*)(Vv + mrow * LDR + hh * 64 + 16 * cq + 4 * kq4); } while (0)
#define L_PROC(c_, q_) do { LAS unsigned char* SB = lds + ((c_) % 3) * SLOTB; \
                                const f32x4 kk = Lk[q_] * kkw_o, kka = kk * La[q_], kp = Lk[q_] * (1.0f + (La[q_] - 1.0f) * kaw_o);     \
                                { float ss = (kk.x * kk.x + kk.y * kk.y) + (kk.z * kk.z + kk.w * kk.w); ss += dppf<0xB1>(ss); ss += dppf<0x4E>(ss); if (kq4 == 0) ssq[((c_) % 3) * 64 + lw * 16 + t] = ss; } \
                                f32x4 P, Px; _Pragma("unroll") for (int e = 0; e < 4; ++e) { const float w_ = Lw[q_][e]; float s = dppm<0x114>(w_); s *= dppm<0x114>(s); s *= dppm<0x118>(s); Px[e] = s; P[e] = s * w_; }     \
                                f32x4 gam, e1, e2, e3, e4; \
                                { LAS f32x4* scr = (LAS f32x4*)(lds + 3 * SLOTB + lw * 1024); scr[lane] = P;                    \
                                  const f32x4 T0 = scr[12 + kq4], T1 = scr[28 + kq4], T2 = scr[44 + kq4], T3 = scr[60 + kq4]; \
                                  const f32x4 one4 = (f32x4){1.f, 1.f, 1.f, 1.f}; \
                                  const f32x4 pref = ((rho >= 1 ? T0 : one4) * (rho >= 2 ? T1 : one4)) * (rho >= 3 ? T2 : one4); \
                                  e2 = P * pref; e1 = Px * pref;                                                                \
                                  gam = (T0 * T1) * (T2 * T3); }                                                               \
                                _Pragma("unroll") for (int e = 0; e < 4; ++e) e3[e] = frcp(e2[e]); e4 = gam * e3;                \
                                const f32x4 kt = kk * e1, rt = Lr[q_] * e2, bt = kka * e3, kl = kp * e3, Bh = kka * e4, Kh = kp * e4; \
                                const int roff = t * 144 + ((lw >> 1) * 4 + kq4) * 16 + (lw & 1) * 8; \
                                { u32x2 w_; w_.x = cvtpk(kt.x, kt.y); w_.y = cvtpk(kt.z, kt.w); *(LAS u32x2*)(SB + O_KT + roff) = w_; w_.x = cvtpk(rt.x, rt.y); w_.y = cvtpk(rt.z, rt.w); *(LAS u32x2*)(SB + O_RT + roff) = w_; \
                                  w_.x = cvtpk(bt.x, bt.y); w_.y = cvtpk(bt.z, bt.w); *(LAS u32x2*)(SB + O_BT + roff) = w_; w_.x = cvtpk(kl.x, kl.y); w_.y = cvtpk(kl.z, kl.w); *(LAS u32x2*)(SB + O_KL + roff) = w_; } \
                                const int toff = (t >> 2) * 8 + (t & 3) * 2; \
                                _Pragma("unroll") for (int e = 0; e < 4; ++e) { *(LAS unsigned short*)(SB + O_KH + (kc + e) * 32 + toff) = BF1(Kh[e]); *(LAS unsigned short*)(SB + O_BH + (kc + e) * 32 + toff) = BF1(Bh[e]); } \
                                if (lw == 0) { _Pragma("unroll") for (int e = 0; e < 4; ++e) *(LAS unsigned short*)(SB + O_VT + (4 * kq4 + e) * 32 + toff) = BF1(Lv[q_][e]); } \
                                if (t == 15) *(LAS f32x4*)(SB + O_GAM + kc * 4) = gam; } while (0)
                            L_ISSUE(0, 0); L_ISSUE(1, 1); L_ISSUE(2, 2); L_ISSUE(3, 3);
                            for (int s0 = 0; s0 < NCH - 4; s0 += 4) {
#pragma unroll
                                for (int q = 0; q < 4; ++q) { const int s = s0 + q;
                                    L_PROC(s, q); L_ISSUE(s + 4, q); STEP_BARRIER(); }
                            }
                            L_PROC(NCH - 4, 0); STEP_BARRIER(); L_PROC(NCH - 3, 1); STEP_BARRIER(); L_PROC(NCH - 2, 2); STEP_BARRIER(); L_PROC(NCH - 1, 3); STEP_BARRIER();
                            STEP_BARRIER(); STEP_BARRIER();
#undef L_ISSUE
#undef L_PROC
                        } else if (wave == 1) {
                            const int r16 = lane & 15, g = lane >> 4;
                            f32x4 rkw[2][2];
#pragma unroll
                            for (int h2 = 0; h2 < 2; ++h2)
#pragma unroll
                                for (int hf = 0; hf < 2; ++hf) rkw[h2][hf] = *(const f32x4*)(rw_rk + hh * 64 + 32 * h2 + 16 * hf + 4 * g);
                            for (int s = 0; s < NCH + 2; ++s) {
                                if (s >= 1 && s <= NCH) { LAS unsigned char* SB = lds + ((s - 1) % 3) * SLOTB;
                                    f32x4 abk = (f32x4){0.f, 0.f, 0.f, 0.f}, akk = abk, abr = abk, akr = abk;
                                    float bon = 0.f;
#pragma unroll
                                    for (int h2 = 0; h2 < 2; ++h2) { const int fo = r16 * 144 + (h2 * 4 + g) * 16;
                                        const bf16x8 fk = *(const LAS bf16x8*)(SB + O_KT + fo), fr_ = *(const LAS bf16x8*)(SB + O_RT + fo), fb = *(const LAS bf16x8*)(SB + O_BT + fo), fl = *(const LAS bf16x8*)(SB + O_KL + fo);
                                        abk = __builtin_amdgcn_mfma_f32_16x16x32_bf16(fk, fb, abk, 0, 0, 0); akk = __builtin_amdgcn_mfma_f32_16x16x32_bf16(fk, fl, akk, 0, 0, 0);
                                        abr = __builtin_amdgcn_mfma_f32_16x16x32_bf16(fr_, fb, abr, 0, 0, 0); akr = __builtin_amdgcn_mfma_f32_16x16x32_bf16(fr_, fl, akr, 0, 0, 0);
                                        { const u32x4 ur = __builtin_bit_cast(u32x4, fr_), ul = __builtin_bit_cast(u32x4, fl);
#pragma unroll
                                          for (int w_ = 0; w_ < 4; ++w_) { const f32x4 rk4_ = rkw[h2][w_ >> 1]; const int e0 = 2 * (w_ & 1);
                                              bon += __builtin_bit_cast(float, ur[w_] << 16) * __builtin_bit_cast(float, ul[w_] << 16) * rk4_[e0] + __builtin_bit_cast(float, ur[w_] & 0xffff0000u) * __builtin_bit_cast(float, ul[w_] & 0xffff0000u) * rk4_[e0 + 1]; } } }
#pragma unroll
                                    for (int i = 0; i < 4; ++i) { const int tt = 4 * g + i; const bool st = r16 < tt, in = r16 <= tt;
                                        const float vbk = st ? abk[i] : 0.f, vkk = st ? akk[i] : 0.f, vbr = in ? abr[i] : 0.f, vkr = in ? akr[i] : 0.f;
                                        *(LAS unsigned short*)(SB + O_ABK + tt * 32 + r16 * 2) = BF1(vbk); *(LAS unsigned short*)(SB + O_AKK + tt * 32 + r16 * 2) = BF1(vkk);
                                        *(LAS unsigned short*)(SB + O_ABR + tt * 32 + r16 * 2) = BF1(vbr); *(LAS unsigned short*)(SB + O_AKR + tt * 32 + r16 * 2) = BF1(vkr);
                                        if ((r16 >> 2) == g) *(LAS float*)(SB + O_DG + (g * 16 + i * 4 + (r16 & 3)) * 4) = vbk; }
                                    bon += xor16f(bon); bon = sum_xor32(bon, lane);
                                    if (cq == 0 && g == 0) BONUS[(rowbase + (size_t)(s - 1) * CH + r16) * 32 + hh] = bon;
                                    { const LAS float* sp_ = (const LAS float*)(lds + 3 * SLOTB + 4096) + ((s - 1) % 3) * 64 + r16;
                                      const float ssn = (sp_[0] + sp_[16]) + (sp_[32] + sp_[48]);
                                      if (g == 0) ((LAS float*)(lds + 3 * SLOTB + 4096 + 768))[((s - 1) % 3) * 16 + r16] = frcp(fmaxf(ssn, 1e-24f)); }
                                }
                                STEP_BARRIER();
                            }
                        } else if (wave == 0) {
                            const int r16 = lane & 15, g = lane >> 4;
                            f32x4 Sacc[4]; u32x4 Sb[2];
#pragma unroll
                            for (int i = 0; i < 4; ++i) Sacc[i] = (f32x4){0.f, 0.f, 0.f, 0.f};
                            Sb[0] = (u32x4){0u, 0u, 0u, 0u}; Sb[1] = Sb[0];
                            for (int s = 0; s < NCH + 2; ++s) {
                                if (s >= 2) { const int c = s - 2; LAS unsigned char* SB = lds + (c % 3) * SLOTB;
                                    const int fo = r16 * 144 + g * 16, ao = r16 * 32 + g * 8;
                                    const bf16x8 kt0 = *(const LAS bf16x8*)(SB + O_KT + fo), kt1 = *(const LAS bf16x8*)(SB + O_KT + fo + 64), rt0 = *(const LAS bf16x8*)(SB + O_RT + fo), rt1 = *(const LAS bf16x8*)(SB + O_RT + fo + 64);
                                    const s16x4 a_kk = *(const LAS s16x4*)(SB + O_AKK + ao), a_kr = *(const LAS s16x4*)(SB + O_AKR + ao), a_br = *(const LAS s16x4*)(SB + O_ABR + ao), a_bk = *(const LAS s16x4*)(SB + O_ABK + ao);
                                    const s16x4 vf = *(const LAS s16x4*)(SB + O_VT + ao);
                                    const f32x4 dg1 = *(const LAS f32x4*)(SB + O_DG + (g * 16 + 4) * 4), dg2 = *(const LAS f32x4*)(SB + O_DG + (g * 16 + 8) * 4), dg3 = *(const LAS f32x4*)(SB + O_DG + (g * 16 + 12) * 4);
                                    const bf16x8 sb0 = __builtin_bit_cast(bf16x8, Sb[0]), sb1 = __builtin_bit_cast(bf16x8, Sb[1]);
                                    f32x4 U = __builtin_amdgcn_mfma_f32_16x16x32_bf16(kt0, sb0, (f32x4){0.f, 0.f, 0.f, 0.f}, 0, 0, 0);
                                    U = __builtin_amdgcn_mfma_f32_16x16x32_bf16(kt1, sb1, U, 0, 0, 0);
                                    U = __builtin_amdgcn_mfma_f32_16x16x16bf16_1k(a_kk, vf, U, 0, 0, 0);
                                    f32x4 Y = __builtin_amdgcn_mfma_f32_16x16x32_bf16(rt0, sb0, (f32x4){0.f, 0.f, 0.f, 0.f}, 0, 0, 0);
                                    Y = __builtin_amdgcn_mfma_f32_16x16x32_bf16(rt1, sb1, Y, 0, 0, 0);
                                    Y = __builtin_amdgcn_mfma_f32_16x16x16bf16_1k(a_kr, vf, Y, 0, 0, 0);
                                    const f32x4 dv = *(const LAS f32x4*)(lds + 3 * SLOTB + 4096 + 768 + ((c % 3) * 16 + 4 * g) * 4);
                                    f32x4 Z = (f32x4){0.f, 0.f, 0.f, 0.f};
#pragma unroll
                                    for (int gb = 0; gb < 4; ++gb) {
                                        const float z0 = U[0] * dv[0], z1 = (U[1] - dg1[0] * z0) * dv[1], z2 = (U[2] - dg2[0] * z0 - dg2[1] * z1) * dv[2], z3 = (U[3] - dg3[0] * z0 - dg3[1] * z1 - dg3[2] * z2) * dv[3];
                                        const bool sel = (g == gb);
                                        Z[0] = sel ? z0 : Z[0]; Z[1] = sel ? z1 : Z[1]; Z[2] = sel ? z2 : Z[2]; Z[3] = sel ? z3 : Z[3];
                                        if (gb < 3) { u32x2 nz; nz.x = sel ? cvtpk(-z0, -z1) : 0u; nz.y = sel ? cvtpk(-z2, -z3) : 0u;
                                            U = __builtin_amdgcn_mfma_f32_16x16x16bf16_1k(a_bk, __builtin_bit_cast(s16x4, nz), U, 0, 0, 0); } }
                                    u32x2 nzp; nzp.x = cvtpk(-Z[0], -Z[1]); nzp.y = cvtpk(-Z[2], -Z[3]); const s16x4 nzf = __builtin_bit_cast(s16x4, nzp);
                                    Y = __builtin_amdgcn_mfma_f32_16x16x16bf16_1k(a_br, nzf, Y, 0, 0, 0);
                                    { float* yd = YRAW + (rowbase + (size_t)c * CH + 4 * g) * D + hh * 64 + 16 * cq + r16;
#pragma unroll
                                      for (int i = 0; i < 4; ++i) yd[(size_t)i * D] = Y[i]; }
#pragma unroll
                                    for (int tau = 0; tau < 4; ++tau) { const f32x4 gm = *(const LAS f32x4*)(SB + O_GAM + (16 * tau + 4 * g) * 4);
                                        const s16x4 kh = *(const LAS s16x4*)(SB + O_KH + (16 * tau + r16) * 32 + g * 8), bhf = *(const LAS s16x4*)(SB + O_BH + (16 * tau + r16) * 32 + g * 8);
                                        f32x4 a = Sacc[tau] * gm; a = __builtin_amdgcn_mfma_f32_16x16x16bf16_1k(kh, vf, a, 0, 0, 0); a = __builtin_amdgcn_mfma_f32_16x16x16bf16_1k(bhf, nzf, a, 0, 0, 0); Sacc[tau] = a; }
#pragma unroll
                                    for (int h2 = 0; h2 < 2; ++h2) { const f32x4 lo = Sacc[2 * h2], hi = Sacc[2 * h2 + 1];
                                        Sb[h2] = (u32x4){cvtpk(lo[0], lo[1]), cvtpk(lo[2], lo[3]), cvtpk(hi[0], hi[1]), cvtpk(hi[2], hi[3])}; }
                                }
                                STEP_BARRIER();
                            }
#pragma unroll
                            for (int tau = 0; tau < 4; ++tau) *(f32x4*)(out + O_PWKV + ((size_t)(bh * 64 + 16 * cq + r16)) * 64 + 16 * tau + 4 * g) = Sacc[tau];
                        } else if (G == 256) {
                            const int w2 = wave - 2;
                            f32x4 Zk[1][4], Za[1][4], Zw[1][4], Zr[1][4], ZS[1], Zkkw[1], Zkaw[1]; float Zv[1][4]; int Ztask[1];
#define S_ISSUE(x_, i_) do { const int stk_ = __builtin_amdgcn_readfirstlane(((i_) * 2 + w2) * 256 + vcu); Ztask[x_] = stk_; const int bs_ = stk_ >> 9, h_ = (stk_ >> 4) & 31, r0s_ = 4 * (stk_ & 15); \
                                ZS[x_] = *(const f32x4*)(st_wkv + (((size_t)bs_ * NH + h_) * 64 + r0s_) * 64 + (unsigned)(rg * 64 + 4 * kq)); Zkkw[x_] = *(const f32x4*)(rw_kk + h_ * 64 + (unsigned)(4 * kq)); Zkaw[x_] = *(const f32x4*)(rw_ka + h_ * 64 + (unsigned)(4 * kq)); \
                                _Pragma("unroll") for (int t = 0; t < DEC_T; ++t) { const size_t rw_ = (size_t)NPR + 4 * bs_ + t; \
                                    Zk[x_][t] = *(const f32x4*)(Kk + rw_ * LDR + h_ * 64 + (unsigned)(4 * kq)); Za[x_][t] = *(const f32x4*)(Aa + rw_ * D + h_ * 64 + (unsigned)(4 * kq)); Zw[x_][t] = *(const f32x4*)(Dec + rw_ * D + h_ * 64 + (unsigned)(4 * kq)); Zr[x_][t] = *(const f32x4*)(Rr + rw_ * LDR + h_ * 64 + (unsigned)(4 * kq)); \
                                    Zv[x_][t] = *(Vv + rw_ * LDR + h_ * 64 + r0s_ + (unsigned)rg); } } while (0)
#define S_FINISH(x_) do { const int stk_ = Ztask[x_]; const int bs_ = stk_ >> 9, h_ = (stk_ >> 4) & 31, row_ = 4 * (stk_ & 15) + rg; \
                                _Pragma("unroll") for (int t = 0; t < DEC_T; ++t) { f32x4 kk, kka, kp; rwkv_derive(Zk[x_][t], Za[x_][t], Zkkw[x_], Zkaw[x_], kk, kka, kp); float y; \
                                    scan_step(ZS[x_], Zw[x_][t], kk, kka, kp, Zr[x_][t], Zv[x_][t], y); \
                                    if (kq == 0) YRAW[((size_t)NPR + 4 * bs_ + t) * D + h_ * 64 + row_] = y; } \
                                *(f32x4*)(out + O_SWKV + (((size_t)bs_ * NH + h_) * 64 + row_) * 64 + 4 * kq) = ZS[x_]; } while (0)
                            for (int p = 0; p < NCH / 2; ++p) {
                                S_ISSUE(0, p); STEP_BARRIER();
                                S_FINISH(0); STEP_BARRIER();
                            }
                            STEP_BARRIER(); STEP_BARRIER();
#undef S_ISSUE
#undef S_FINISH
                        } else {
                            for (int s = 0; s < NCH + 2; ++s) STEP_BARRIER();
                        }
                    }
#undef BF1
#undef STEP_BARRIER
                    if (G != 256) for (int task = gw; task < DEC_B * NH * 16; task += NGW) SAMPLE_TASK(task);
#undef SAMPLE_TASK
#undef SAMPLE_ISSUE
#undef SAMPLE_FINISH
                }
                PH_END
                PH_BEGIN
                {
                    const float* Rr = RKV; const float* Kk = RKV + D; const float* Vv = RKV + 2 * D;
                    const float* Aa = DAG + (size_t)M * D; const bf16_t* Gg = (const bf16_t*)(DAG + 2 * (size_t)M * D);
                    QROWS_SETUP (void)qc;
                    for (int it = wave; it < qnit; it += NWAVES) { const int m = QROW(it); if (QSKIP(it, m)) continue; const size_t ro = (size_t)m * D, ro2 = (size_t)m * LDR;
#pragma unroll 2
                        for (int j = 0; j < 8; ++j) { const int e = 4 * lane + 256 * j;
                            const f32x4 y = *(const f32x4*)(YRAW + ro + e);
                            const float mean = row16_sum((y.x + y.y) + (y.z + y.w)) * (1.0f / 64.0f);
                            const f32x4 dv = y - mean; const float var = row16_sum((dv.x * dv.x + dv.y * dv.y) + (dv.z * dv.z + dv.w * dv.w)) * (1.0f / 64.0f);
                            const float rstd = 1.0f / sqrtf(var + GN_EPS);
                            const f32x4 gw4 = *(const f32x4*)(rw_gn_w + e), gb4 = *(const f32x4*)(rw_gn_b + e);
                            const f32x4 v4 = *(const f32x4*)(Vv + ro2 + e), g4 = bf4(*(const u32x2*)(Gg + ro + e));
                            float bs;
                            if (m < NPR) bs = BONUS[(size_t)m * 32 + (e >> 6)];
                            else { const f32x4 r4 = *(const f32x4*)(Rr + ro2 + e), k4 = *(const f32x4*)(Kk + ro2 + e), a4 = *(const f32x4*)(Aa + ro + e);
                                const f32x4 kaw = *(const f32x4*)(rw_ka + e), rk4 = *(const f32x4*)(rw_rk + e);
                                const f32x4 kp = k4 * (1.0f + (a4 - 1.0f) * kaw); const f32x4 pr = r4 * kp * rk4;
                                bs = row16_sum((pr.x + pr.y) + (pr.z + pr.w)); }
                            const f32x4 o = ((dv * rstd) * gw4 + gb4 + bs * v4) * g4;
                            u32x2 w; w.x = cvtpk(o.x, o.y); w.y = cvtpk(o.z, o.w); *(u32x2*)(HA + ro + e) = w; } }
                }
                PH_END
                ++qslot;
            } else {
                PH_BEGIN
                {
                    QROWS_SETUP
                    for (;;) { int it; QPOP(it); if (it >= qnit) break; const int m = QROW(it); if (QSKIP(it, m)) continue; const int b = bidx_of_row(m);
                        const float* mb = (MOD + (size_t)layer * NCB * NMOD * D) + (size_t)b * NMOD * D + 3 * D;
                        Pend pd{nullptr, 0, nullptr, nullptr, 0.f}; MAKE_PEND(pd, m, b, 11, layer, 2, nullptr, 0.5f);
                        f32x4 h[8]; norm_mod_row(XBUF(xcur) + (size_t)m * D, true, (norm_g + (size_t)(layer * 3 + sub) * D), mb, mb + D, lane, h, XBUF(xcur ^ 1) + (size_t)m * D, pd);
                        store_bf16_row(HA + (size_t)m * D, h, lane); }
                }
                PH_END
                ++qslot;
                xcur ^= 1;
                PH_BEGIN
                {
                    pg8::Sched<pg8::ASel0, pg8::SplitOrder<34, 10, 32, PMS_QKV, 2>> S; S.ord.init(G, bx); S.A = (const char*)HA; S.Bt = (const char*)W_QKV; S.tstep = (size_t)256 * D * 2; S.astride = 0;
                    pg8::EpiF32 E{QKV, QKVW, sw_bqkv, SLAB, ROW0_QKV, NROWS_QKV};
                    pg8::gemm_phase(lds, tid, D, S, E);
                }
                PH_END
                PH_BEGIN
                {
                    const int i0 = 4 * (lane & 7), hsel = lane >> 3; const f32x4 invf = *(const f32x4*)(INV_FREQ + i0);
                    QROWS_SETUP (void)qc;
                    for (int it = wave; it < qnit; it += NWAVES) { const int m = QROW(it); if (QSKIP(it, m)) continue;
                        const int pos = m < NPR ? (m & 4095) : 8192 + ((m - NPR) & 3);
                        f32x4 cs, sn;
#pragma unroll
                        for (int e = 0; e < 4; ++e) { const float ang = (float)pos * invf[e]; const double a = (double)ang * 0.15915494309189535; const float fr = (float)(a - __builtin_rint(a));
                            cs[e] = __builtin_amdgcn_cosf(fr); sn[e] = __builtin_amdgcn_sinf(fr); }
                        const float* qrow = QKV + (size_t)m * QKVW;
                        const bool spl = m >= ROW0_QKV; const float* sl0 = SLAB + (size_t)(spl ? m - ROW0_QKV : 0) * QKVW; const float* sl1 = sl0 + (size_t)NROWS_QKV * QKVW; const float* bq = sw_bqkv;
#define QV4(c_) (spl ? (*(const f32x4*)(sl0 + (c_)) + *(const f32x4*)(sl1 + (c_))) + *(const f32x4*)(bq + (c_)) : *(const f32x4*)(qrow + (c_)))
#pragma unroll
                        for (int p = 0; p < 4; ++p) { const int hd0 = (8 * p + hsel) * 64 + i0; const f32x4 x1 = QV4(hd0), x2 = QV4(hd0 + 32);
                            const f32x4 o1 = (x1 * cs - x2 * sn) * QSCALE, o2 = (x2 * cs + x1 * sn) * QSCALE;
                            u32x2 w1, w2; w1.x = cvtpk(o1.x, o1.y); w1.y = cvtpk(o1.z, o1.w); w2.x = cvtpk(o2.x, o2.y); w2.y = cvtpk(o2.z, o2.w);
                            *(u32x2*)(QB + (size_t)m * D + hd0) = w1; *(u32x2*)(QB + (size_t)m * D + hd0 + 32) = w2; }
                        float* kout = nullptr; float* vout = nullptr;
                        if (m < NPR) { const int t = m & 4095; if (t >= SEQ - WIN) { const size_t o = ((size_t)(m >> 12) * WIN + (t - (SEQ - WIN))) * 256; kout = out + O_PK + o; vout = out + O_PV + o; } }
                        else { const int bs = (m - NPR) >> 2, t = (m - NPR) & 3; const size_t o = ((size_t)bs * WIN + (WIN - DEC_T) + t) * 256; kout = out + O_SK + o; vout = out + O_SV + o; }
                        if (hsel < 4) { const int hd0 = hsel * 64 + i0; const f32x4 x1 = QV4(D + hd0), x2 = QV4(D + hd0 + 32);
                            const f32x4 o1 = x1 * cs - x2 * sn, o2 = x2 * cs + x1 * sn;
                            u32x2 w1, w2; w1.x = cvtpk(o1.x, o1.y); w1.y = cvtpk(o1.z, o1.w); w2.x = cvtpk(o2.x, o2.y); w2.y = cvtpk(o2.z, o2.w);
                            *(u32x2*)(KB + (size_t)m * 256 + hd0) = w1; *(u32x2*)(KB + (size_t)m * 256 + hd0 + 32) = w2;
                            if (kout) { *(f32x4*)(kout + hd0) = o1; *(f32x4*)(kout + hd0 + 32) = o2; } }
                        { const int vc = D + 256 + 4 * lane; const f32x4 v4 = QV4(vc); u32x2 w; w.x = cvtpk(v4.x, v4.y); w.y = cvtpk(v4.z, v4.w); *(u32x2*)(VB + (size_t)m * 256 + 4 * lane) = w;
                          if (vout) *(f32x4*)(vout + 4 * lane) = v4; }
                    }
#undef QV4
                    for (int idx = gw * 64 + lane; idx < DEC_B * (WIN - DEC_T) * 64; idx += NGW * 64) { const int bs = idx / ((WIN - DEC_T) * 64), rem = idx % ((WIN - DEC_T) * 64);
                        const size_t src = (size_t)bs * WIN * 256 + (size_t)DEC_T * 256 + (size_t)rem * 4, dst = (size_t)bs * WIN * 256 + (size_t)rem * 4;
                        *(f32x4*)(out + O_SK + dst) = *(const f32x4*)(cache_k + src); *(f32x4*)(out + O_SV + dst) = *(const f32x4*)(cache_v + src); }
                }
                PH_END
                ++qslot;
                PH_BEGIN
                {
                    constexpr int KST = 144, VST = 520;
                    LAS unsigned char* Ks = lds; LAS unsigned char* Vt = lds + 256 * KST;
                    const int r = lane & 31, hf = lane >> 5;
                    for (int u = vcu; u < 256; u += G) {
                        const int b = u >> 7, kvh = (u >> 5) & 3, blk = u & 31;
                        __syncthreads();
                        for (int idx = tid; idx < 2048; idx += NTHREADS) { const int key = idx >> 3, ch = idx & 7; const int kpos = 128 * (blk - 1) + key;
                            u32x4 kv = (u32x4){0u, 0u, 0u, 0u}, vv = (u32x4){0u, 0u, 0u, 0u};
                            if (kpos >= 0) { const size_t o = ((size_t)b * SEQ + kpos) * 256 + kvh * 64 + 8 * ch; kv = *(const u32x4*)(KB + o); vv = *(const u32x4*)(VB + o); }
                            *(LAS u32x4*)(Ks + key * KST + ch * 16) = kv;
                            LAS bf16_t* vt = (LAS bf16_t*)(Vt + (8 * ch) * VST) + key;
                            vt[0 * (VST / 2)] = (bf16_t)(vv.x & 0xffffu); vt[1 * (VST / 2)] = (bf16_t)(vv.x >> 16); vt[2 * (VST / 2)] = (bf16_t)(vv.y & 0xffffu); vt[3 * (VST / 2)] = (bf16_t)(vv.y >> 16);
                            vt[4 * (VST / 2)] = (bf16_t)(vv.z & 0xffffu); vt[5 * (VST / 2)] = (bf16_t)(vv.z >> 16); vt[6 * (VST / 2)] = (bf16_t)(vv.w & 0xffffu); vt[7 * (VST / 2)] = (bf16_t)(vv.w >> 16); }
                        __syncthreads();
                        const int hq = kvh * 8 + wave; const float sink2 = sw_sink[hq] * LOG2E;
                        for (int sb = 0; sb < 4; ++sb) {
                            const size_t qrow = (size_t)b * SEQ + 128 * blk + 32 * sb + r;
                            bf16x8 qf[4];
#pragma unroll
                            for (int kk = 0; kk < 4; ++kk) qf[kk] = *(const bf16x8*)(QB + qrow * D + hq * 64 + 16 * kk + 8 * hf);
                            f32x16 s[5];
#pragma unroll
                            for (int i = 0; i < 5; ++i) { const int jt = sb + i;
#pragma unroll
                                for (int e = 0; e < 16; ++e) s[i][e] = 0.f;
#pragma unroll
                                for (int kk = 0; kk < 4; ++kk) { const bf16x8 a = *(const LAS bf16x8*)(Ks + (32 * jt + r) * KST + (16 * kk + 8 * hf) * 2);
                                    s[i] = __builtin_amdgcn_mfma_f32_32x32x16_bf16(a, qf[kk], s[i], 0, 0, 0); } }
                            float mx = -3.0e38f;
#pragma unroll
                            for (int i = 0; i < 5; ++i) { const bool tile_ok = (blk > 0) || (sb + i >= 4);
#pragma unroll
                                for (int e = 0; e < 16; ++e) { const int cr = (e & 3) + 8 * (e >> 2) + 4 * hf;
                                    bool ok = tile_ok; if (i == 0) ok = ok && (cr > r); if (i == 4) ok = ok && (cr <= r);
                                    s[i][e] = ok ? s[i][e] : -3.0e38f; mx = fmaxf(mx, s[i][e]); } }
                            mx = max_xor32(mx, lane); const float m2 = fmaxf(mx, sink2);
                            float sum = 0.f;
#pragma unroll
                            for (int i = 0; i < 5; ++i)
#pragma unroll
                                for (int e = 0; e < 16; ++e) { s[i][e] = fexp2(s[i][e] - m2); sum += s[i][e]; }
                            sum = sum_xor32(sum, lane);
                            const float inv = 1.0f / (sum + fexp2(sink2 - m2));
                            f32x16 o[2];
#pragma unroll
                            for (int e = 0; e < 16; ++e) { o[0][e] = 0.f; o[1][e] = 0.f; }
#pragma unroll
                            for (int i = 0; i < 5; ++i) { const int jt = sb + i;
#pragma unroll
                                for (int s2 = 0; s2 < 2; ++s2) {
                                    u32x4 pw; pw.x = cvtpk(s[i][8 * s2 + 0] * inv, s[i][8 * s2 + 1] * inv); pw.y = cvtpk(s[i][8 * s2 + 2] * inv, s[i][8 * s2 + 3] * inv);
                                    pw.z = cvtpk(s[i][8 * s2 + 4] * inv, s[i][8 * s2 + 5] * inv); pw.w = cvtpk(s[i][8 * s2 + 6] * inv, s[i][8 * s2 + 7] * inv);
                                    const bf16x8 pa = __builtin_bit_cast(bf16x8, pw);
#pragma unroll
                                    for (int dd = 0; dd < 2; ++dd) { const LAS unsigned char* vp = Vt + (32 * dd + r) * VST + (32 * jt + 16 * s2 + 4 * hf) * 2;
                                        const u32x2 lo = *(const LAS u32x2*)(vp), hi2 = *(const LAS u32x2*)(vp + 16);
                                        const u32x4 vb = (u32x4){lo.x, lo.y, hi2.x, hi2.y};
                                        o[dd] = __builtin_amdgcn_mfma_f32_32x32x16_bf16(pa, __builtin_bit_cast(bf16x8, vb), o[dd], 0, 0, 0); } } }
                            bf16_t* ob = HA + ((size_t)b * SEQ + 128 * blk + 32 * sb) * D + hq * 64 + r;
#pragma unroll
                            for (int e = 0; e < 16; ++e) { const int cr = (e & 3) + 8 * (e >> 2) + 4 * hf;
                                ob[(size_t)cr * D] = (bf16_t)(cvtpk(o[0][e], 0.f) & 0xffffu); ob[(size_t)cr * D + 32] = (bf16_t)(cvtpk(o[1][e], 0.f) & 0xffffu); }
                        }
                    }
                    {
                        const int rg = lane >> 4, kq = lane & 15;
                        for (int task = gw; task < DEC_B * NH; task += NGW) {
                            const int bs = task >> 5, hq = task & 31, kvh = hq >> 3; const int m0 = NPR + 4 * bs;
                            f32x4 q4[4], acc[4]; float mrun[4], sum[4];
                            const float sink2 = sw_sink[hq] * LOG2E;
#pragma unroll
                            for (int t = 0; t < 4; ++t) { const u32x2 qw = *(const u32x2*)(QB + (size_t)(m0 + t) * D + hq * 64 + 4 * kq);
                                q4[t] = (f32x4){bf2f((unsigned short)(qw.x & 0xffffu)), bf2f((unsigned short)(qw.x >> 16)), bf2f((unsigned short)(qw.y & 0xffffu)), bf2f((unsigned short)(qw.y >> 16))};
                                mrun[t] = sink2; sum[t] = 0.f; acc[t] = (f32x4){0.f, 0.f, 0.f, 0.f}; }
                            const float* ckb = cache_k + (size_t)bs * WIN * 256 + kvh * 64 + 4 * kq; const float* cvb = cache_v + (size_t)bs * WIN * 256 + kvh * 64 + 4 * kq;
                            const float* nkb = out + O_SK + ((size_t)bs * WIN + (WIN - DEC_T)) * 256 + kvh * 64 + 4 * kq; const float* nvb = out + O_SV + ((size_t)bs * WIN + (WIN - DEC_T)) * 256 + kvh * 64 + 4 * kq;
#pragma unroll 3
                            for (int it = 0; it < 33; ++it) { const int j = 4 * it + rg;
                                const f32x4 k4 = *(const f32x4*)(j < WIN ? ckb + (size_t)j * 256 : nkb + (size_t)(j - WIN) * 256);
                                const f32x4 v4 = *(const f32x4*)(j < WIN ? cvb + (size_t)j * 256 : nvb + (size_t)(j - WIN) * 256);
#pragma unroll
                                for (int t = 0; t < 4; ++t) {
                                    float d = (q4[t].x * k4.x + q4[t].y * k4.y) + (q4[t].z * k4.z + q4[t].w * k4.w); d = row16_sum(d);
                                    const bool ok = j < WIN ? (j >= t + 1) : (j - WIN <= t);
                                    if (ok) { const float mn = fmaxf(mrun[t], d); const float scl = fexp2(mrun[t] - mn), p = fexp2(d - mn); sum[t] = sum[t] * scl + p; acc[t] = acc[t] * scl + p * v4; mrun[t] = mn; } } }
#pragma unroll
                            for (int t = 0; t < 4; ++t) {
                                float mall = fmaxf(mrun[t], xor16f(mrun[t])); mall = max_xor32(mall, lane);
                                const float f = fexp2(mrun[t] - mall); float sm = sum[t] * f; f32x4 a = acc[t] * f;
                                sm += xor16f(sm); sm = sum_xor32(sm, lane);
#pragma unroll
                                for (int e = 0; e < 4; ++e) { float t_ = a[e]; t_ += xor16f(t_); a[e] = sum_xor32(t_, lane); }
                                const float inv = 1.0f / (sm + fexp2(sink2 - mall));
                                if (rg == 0) { u32x2 w; w.x = cvtpk(a.x * inv, a.y * inv); w.y = cvtpk(a.z * inv, a.w * inv); *(u32x2*)(HA + (size_t)(m0 + t) * D + hq * 64 + 4 * kq) = w; } }
                        }
                    }
                }
                PH_END
            }
            if (sub == 1) {
                PH_BEGIN
                {
                    pg8::Sched<pg8::ASel0, pg8::SplitOrder<34, 8, 32, 32, 8>> S; S.ord.init(G, bx); S.A = (const char*)HA; S.Bt = (const char*)(layer == 0 ? W_RWO : W_SWO); S.tstep = (size_t)256 * D * 2; S.astride = 0;
                    pg8::EpiDelta E{(bf16_t*)DELTA, SLAB};
                    pg8::gemm_phase(lds, tid, D, S, E);
                }
                PH_END
            }
        }
    }
    PH_BEGIN
    {
        QROWS_SETUP
        for (;;) { int it; QPOP(it); if (it >= qnit) break; const int m = QROW(it); if (QSKIP(it, m)) continue;
            f32x4 v[8]; float ss = 0.f; Pend pd{nullptr, 0, nullptr, nullptr, 0.f}; MAKE_PEND(pd, m, bidx_of_row(m), 11, 1, 8, nullptr, 0.5f);
            load_x_row(XBUF(xcur) + (size_t)m * D, true, lane, v, pd);
#pragma unroll
            for (int j = 0; j < 8; ++j) ss += (v[j].x * v[j].x + v[j].y * v[j].y) + (v[j].z * v[j].z + v[j].w * v[j].w);
            ss = wave_sum(ss); const float rs = 1.0f / sqrtf(ss * (1.0f / D) + RMS_EPS);
#pragma unroll
            for (int j = 0; j < 8; ++j) ((f32x4*)(out + O_Y + (size_t)m * D))[lane + 64 * j] = v[j] * rs * ((const f32x4*)final_g)[lane + 64 * j];
        }
    }
#if PROBE_MASK
    PH_END
    PH_BEGIN
    {
        const size_t offs[11] = {0, (size_t)NPR * D, O_PWKV, O_PSHIFT, O_PK, O_PV, O_SWKV, O_SSHIFT, O_SK, O_SV, O_END};
#pragma unroll
        for (int j = 0; j < 10; ++j) if ((PROBE_MASK >> j) & 1) {
            for (size_t i = offs[j] + (size_t)gw * 64 + lane; i < offs[j + 1]; i += (size_t)NGW * 64) out[i] *= 0.9f; }
    }
#endif
    PH_END_LAST
#undef PH_BEGIN
#undef PH_END
#undef PH_END_LAST
#undef PH_SETUP
#undef PH_BARRIER
}

#undef x_prompt
#undef x_sample
#undef st_wkv
#undef st_shift
#undef cache_k
#undef cache_v
#undef c_prompt
#undef c_sample
#undef norm_g
#undef w_ada
#undef b_ada
#undef w_ffn_in
#undef w_ffn_out
#undef rw_mu
#undef rw_wrkv
#undef rw_w0
#undef rw_w1
#undef rw_w2
#undef rw_a0
#undef rw_a1
#undef rw_a2
#undef rw_g1
#undef rw_g2
#undef rw_kk
#undef rw_ka
#undef rw_rk
#undef rw_gn_w
#undef rw_gn_b
#undef rw_wo
#undef sw_wqkv
#undef sw_bqkv
#undef sw_sink
#undef sw_wo
#undef sw_bo
#undef final_g
#undef W_ADA
#undef W_FIN
#undef W_FOUT
#undef W_RKVL1
#undef W_L2
#undef W_RWO
#undef W_QKV
#undef W_SWO
#undef CS
#undef MOD
#undef X
#undef HA
#undef ACT
#undef XA6
#undef DAG
#undef RKV
#undef L1OUT
#undef YRAW
#undef QKV
#undef QB
#undef KB
#undef VB
#undef SLAB
#undef DELTA
#undef XBUF
#undef out
extern "C" void kernel_launch(void* const* d_in, const int* in_sizes, int n_in, void* d_out, int out_size, void* d_ws, size_t ws_size, hipStream_t stream) {
    static int grid = 0;
    if (grid == 0) {
        if (n_in != 35 || (size_t)out_size != O_END || ws_size < WS_END) { fprintf(stderr, "kernel_launch: unexpected sizes: n_in %d out %d ws %zu (need %zu)\n", n_in, out_size, ws_size, (size_t)WS_END); grid = -1; return; }
        int dev = 0, cus = 0, per_cu = 0;
        if (hipGetDevice(&dev) != hipSuccess || hipDeviceGetAttribute(&cus, hipDeviceAttributeMultiprocessorCount, dev) != hipSuccess) { grid = -1; return; }
        if (hipFuncSetAttribute((const void*)mk_fwd, hipFuncAttributeMaxDynamicSharedMemorySize, LDS_BYTES) != hipSuccess) { fprintf(stderr, "kernel_launch: hipFuncSetAttribute failed\n"); grid = -1; return; }
        if (hipOccupancyMaxActiveBlocksPerMultiprocessor(&per_cu, (const void*)mk_fwd, NTHREADS, LDS_BYTES) != hipSuccess || per_cu < 1) fprintf(stderr, "kernel_launch: occupancy query says %d\n", per_cu);
        (void)hipGetLastError();
        grid = cus;
    }
    if (grid < 0) return;
    (void)hipMemsetAsync((char*)d_ws + WS_CTL, 0, CTL_ZERO_BYTES, stream);
    Args a{};
    for (int i = 0; i < 35; ++i) a.in[i] = (const float*)d_in[i];
    a.out = (float*)d_out; a.ws = (unsigned char*)d_ws;
#if MK_PER_PHASE
    for (int p = 0; p < 28; ++p) { a.ph_lo = p; a.ph_hi = p + 1; hipLaunchKernelGGL(mk_fwd, dim3(grid), dim3(NTHREADS), LDS_BYTES, stream, a); }
#else
    a.ph_lo = 0; a.ph_hi = 1 << 20;
    hipLaunchKernelGGL(mk_fwd, dim3(grid), dim3(NTHREADS), LDS_BYTES, stream, a);
#endif
    const hipError_t le = hipPeekAtLastError();
    if (le != hipSuccess) fprintf(stderr, "kernel_launch: launch failed: %s\n", hipGetErrorName(le));
}
```
